# Optimizing an MI355X kernel written in HIP

```python
import jax, jax.numpy as jnp
from jax import lax
import numpy as np

D_MODEL = 4096
BATCH = 2
SEQ = 4096
DEPTH = 1

CTX_LEN = 256
GRID_W = 64
HG_HEADS = 16
HG_DIM = 128
HG_WIDTH = HG_HEADS * HG_DIM
RET_HEADS = 16
RET_DK = 128
RET_DV = 128
RET_QK_WIDTH = RET_HEADS * RET_DK
RET_V_WIDTH = RET_HEADS * RET_DV
RET_DECAY_EXP_MIN = 5.0
RET_DECAY_EXP_MAX = 12.0
D_FF = 4 * D_MODEL
CHUNK = 64
ROPE_BASE = 10000.0
EPS = 1e-6
ADALN_SCALE = 0.3
STATE_SPLITS = (HG_WIDTH, HG_WIDTH, HG_WIDTH, RET_QK_WIDTH, RET_V_WIDTH)
READ_SPLITS = (HG_WIDTH, HG_WIDTH, RET_QK_WIDTH, RET_V_WIDTH, D_MODEL, D_MODEL)
N_STATE_COLS = sum(STATE_SPLITS)
N_IN_COLS = N_STATE_COLS + sum(READ_SPLITS)

kernel_name = "hybrid_hgrn2_retention_dit_block"

F32 = jnp.float32


def _rmsnorm(x, gain):
    xf = x.astype(F32)
    y = xf * lax.rsqrt(jnp.mean(xf * xf, axis=-1, keepdims=True) + EPS)
    return (y * gain.astype(F32)).astype(x.dtype)


def _head_rmsnorm(o, gain):
    return o * lax.rsqrt(jnp.mean(o * o, axis=-1, keepdims=True) + EPS) * gain.astype(F32)


def _head_layernorm(o):
    mu = jnp.mean(o, axis=-1, keepdims=True)
    oc = o - mu
    return oc * lax.rsqrt(jnp.mean(oc * oc, axis=-1, keepdims=True) + EPS)


def _split_cols(a, sizes):
    out, off = [], 0
    for s in sizes:
        out.append(a[..., off:off + s])
        off += s
    return out


def _split_heads(a, n_heads):
    b, t, w = a.shape
    return a.reshape(b, t, n_heads, w // n_heads).transpose(0, 2, 1, 3)


def _merge_heads(a):
    b, h, t, d = a.shape
    return a.transpose(0, 2, 1, 3).reshape(b, t, h * d)


def _flip(a):
    return None if a is None else jnp.flip(a, axis=2)


def _rope_2d(t_len):
    rows = t_len // GRID_W
    pos = jnp.arange(rows * GRID_W)
    row = (pos // GRID_W).astype(F32)
    col = (pos % GRID_W).astype(F32)
    n_freq = RET_DK // 4
    inv_freq = ROPE_BASE ** (-jnp.arange(n_freq, dtype=F32) / n_freq)
    ang = jnp.concatenate([row[:, None] * inv_freq, col[:, None] * inv_freq], axis=-1)
    return jnp.cos(ang), jnp.sin(ang)


def _apply_rope(a, cos, sin):
    a1, a2 = a[..., 0::2], a[..., 1::2]
    return jnp.stack([a1 * cos - a2 * sin, a1 * sin + a2 * cos], axis=-1).reshape(a.shape)


def _chunk_scan(q, k, v, log_f, s0):
    b, h, t, _ = k.shape
    n = t // CHUNK

    def to_chunks(a):
        return jnp.moveaxis(a.astype(F32).reshape(b, h, n, CHUNK, a.shape[-1]), 2, 0)

    kc, vc, fc = to_chunks(k), to_chunks(v), to_chunks(log_f)

    def update(state, ki, vi, cum):
        last = cum[..., -1:, :]
        k_dec = ki * jnp.exp(last - cum)
        return jnp.exp(last[..., 0, :])[..., None] * state + jnp.einsum('bhck,bhcv->bhkv', k_dec, vi)

    if q is None:
        def step_state(state, inp):
            ki, vi, fi = inp
            return update(state, ki, vi, jnp.cumsum(fi, axis=-2)), None
        s_final, _ = lax.scan(step_state, s0, (kc, vc, fc))
        return None, s_final

    qc = to_chunks(q)
    mask = jnp.tril(jnp.ones((CHUNK, CHUNK), dtype=bool))[:, :, None]

    def step(state, inp):
        qi, ki, vi, fi = inp
        cum = jnp.cumsum(fi, axis=-2)
        diff = jnp.where(mask, cum[..., :, None, :] - cum[..., None, :, :], -jnp.inf)
        decay = jnp.exp(diff)
        if fi.shape[-1] == 1:
            scores = jnp.einsum('bhtk,bhsk->bhts', qi, ki) * decay[..., 0]
        else:
            scores = jnp.einsum('bhtk,bhsk,bhtsk->bhts', qi, ki, decay)
        o = (jnp.einsum('bhck,bhkv->bhcv', qi * jnp.exp(cum), state)
             + jnp.einsum('bhts,bhsv->bhtv', scores, vi))
        return update(state, ki, vi, cum), o

    s_final, oc = lax.scan(step, s0, (qc, kc, vc, fc))
    return jnp.moveaxis(oc, 0, 2).reshape(b, h, t, -1), s_final


def _prefix_bidirectional_scan(q_ctx, k_ctx, v_ctx, lf_ctx, q_lat, k_lat, v_lat, lf_lat):
    b, h, _, dk = k_lat[0].shape
    dv = v_lat.shape[-1]
    zero = jnp.zeros((b, h, dk, dv), F32)
    oc_f, sc_f = _chunk_scan(q_ctx, k_ctx[0], v_ctx, lf_ctx[0], zero)
    oc_b, sc_b = _chunk_scan(_flip(q_ctx), _flip(k_ctx[1]), _flip(v_ctx), _flip(lf_ctx[1]), zero)
    ox_f, _ = _chunk_scan(q_lat, k_lat[0], v_lat, lf_lat[0], sc_f)
    ox_b, _ = _chunk_scan(_flip(q_lat), _flip(k_lat[1]), _flip(v_lat), _flip(lf_lat[1]), sc_b)
    o_ctx = None if q_ctx is None else oc_f + _flip(oc_b)
    return o_ctx, ox_f + _flip(ox_b)


def _state_inputs(p, lb, ret_log_decay, rope):
    hg_i, hg_f_fwd, hg_f_bwd, ret_k, ret_v = _split_cols(p, STATE_SPLITS)
    b, t, _ = p.shape

    def hgrn_gates(z, lbd):
        f = lbd + (1.0 - lbd) * jax.nn.sigmoid(z.astype(F32))
        return _split_heads(1.0 - f, HG_HEADS), _split_heads(jnp.log(f), HG_HEADS)

    k_f, lf_f = hgrn_gates(hg_f_fwd, lb[0])
    k_b, lf_b = hgrn_gates(hg_f_bwd, lb[1])
    rk = _split_heads(ret_k.astype(F32), RET_HEADS) * RET_DK ** -0.5
    if rope is not None:
        rk = _apply_rope(rk, *rope)
    rlf = [jnp.broadcast_to(ret_log_decay[d][None, :, None, None], (b, RET_HEADS, t, 1)) for d in range(2)]
    return dict(hg_i=_split_heads(hg_i, HG_HEADS), hg_k=(k_f, k_b), hg_lf=(lf_f, lf_b),
                ret_k=(rk, rk), ret_v=_split_heads(ret_v, RET_HEADS), ret_lf=(rlf[0], rlf[1]))


def _read_inputs(p, rope):
    hg_q, hg_g, ret_q, ret_g, gate_hgrn, gate_ret = _split_cols(p, READ_SPLITS)
    q_h = _split_heads(jax.nn.silu(hg_q.astype(F32)) * HG_DIM ** -0.5, HG_HEADS)
    q_r = _split_heads(ret_q.astype(F32), RET_HEADS)
    if rope is not None:
        q_r = _apply_rope(q_r, *rope)
    return dict(hg_q=q_h, hg_g=hg_g, ret_q=q_r, ret_g=ret_g, gate_hgrn=gate_hgrn, gate_ret=gate_ret)


def _mixer_output(hg_o, ret_o, rd, hg_gain, w_bh, w_br, w_o, dtype):
    y_hg = _merge_heads(_head_rmsnorm(hg_o, hg_gain)).astype(dtype) * jax.nn.silu(rd['hg_g'])
    y_ret = _merge_heads(_head_layernorm(ret_o)).astype(dtype) * jax.nn.silu(rd['ret_g'])
    merged = (jax.nn.sigmoid(rd['gate_hgrn']) * (y_hg @ w_bh)
              + jax.nn.sigmoid(rd['gate_ret']) * (y_ret @ w_br))
    return merged @ w_o


def _sq_relu_mlp(h, w1, w2):
    return jnp.square(jax.nn.relu(h @ w1)) @ w2


def setup_inputs(seed: int = 0) -> dict:
    key = jax.random.key(seed)
    ks = jax.random.split(key, 18)

    def nrm(k, shape, scale):
        return jax.random.normal(k, shape, F32) * scale

    e = np.linspace(RET_DECAY_EXP_MIN, RET_DECAY_EXP_MAX, RET_HEADS).astype(np.float32)
    base_logit = jnp.asarray(np.log(np.exp2(e) - 1.0).astype(np.float32))
    return {
        "x": nrm(ks[0], (BATCH, SEQ, D_MODEL), 1.0),
        "c": nrm(ks[1], (BATCH, D_MODEL), 1.0),
        "ctx": nrm(ks[2], (BATCH, CTX_LEN, D_MODEL), 1.0),
        "c_ctx": nrm(ks[3], (D_MODEL,), 1.0),
        "w_mod": nrm(ks[4], (DEPTH, D_MODEL, 6 * D_MODEL), ADALN_SCALE * D_MODEL ** -0.5),
        "b_mod": nrm(ks[5], (DEPTH, 6 * D_MODEL), 0.02),
        "norm1_g": 1.0 + nrm(ks[6], (DEPTH, D_MODEL), 0.02),
        "norm2_g": 1.0 + nrm(ks[7], (DEPTH, D_MODEL), 0.02),
        "w_in": nrm(ks[8], (DEPTH, D_MODEL, N_IN_COLS), D_MODEL ** -0.5),
        "hg_lb_logits": nrm(ks[9], (DEPTH + 1, 2, HG_WIDTH), 0.1),
        "hg_norm_g": 1.0 + nrm(ks[10], (DEPTH, HG_DIM), 0.02),
        "ret_decay_logit": base_logit + nrm(ks[11], (DEPTH, 2, RET_HEADS), 0.1),
        "w_branch_hgrn": nrm(ks[12], (DEPTH, HG_WIDTH, D_MODEL), HG_WIDTH ** -0.5),
        "w_branch_ret": nrm(ks[13], (DEPTH, RET_V_WIDTH, D_MODEL), RET_V_WIDTH ** -0.5),
        "w_out": nrm(ks[14], (DEPTH, D_MODEL, D_MODEL), D_MODEL ** -0.5),
        "w_ff1": nrm(ks[15], (DEPTH, D_MODEL, D_FF), D_MODEL ** -0.5),
        "w_ff2": nrm(ks[16], (DEPTH, D_FF, D_MODEL), D_FF ** -0.5),
        "final_norm_g": 1.0 + nrm(ks[17], (D_MODEL,), 0.02),
    }


def reference(x, c, ctx, c_ctx, w_mod, b_mod, norm1_g, norm2_g, w_in, hg_lb_logits, hg_norm_g,
              ret_decay_logit, w_branch_hgrn, w_branch_ret, w_out, w_ff1, w_ff2, final_norm_g):
    rope = _rope_2d(x.shape[1])
    lower_bounds = jnp.cumsum(jax.nn.softmax(hg_lb_logits.astype(F32), axis=0), axis=0)[:DEPTH]
    ret_log_decay = jax.nn.log_sigmoid(ret_decay_logit.astype(F32))
    silu_c = jax.nn.silu(c)
    silu_cc = jax.nn.silu(c_ctx)

    for layer in range(DEPTH):
        keep_ctx = layer + 1 < DEPTH
        mod_x = (silu_c @ w_mod[layer] + b_mod[layer])[:, None, :]
        mod_c = silu_cc @ w_mod[layer] + b_mod[layer]
        shift1_x, scale1_x, gate1_x, shift2_x, scale2_x, gate2_x = jnp.split(mod_x, 6, axis=-1)
        shift1_c, scale1_c, gate1_c, shift2_c, scale2_c, gate2_c = jnp.split(mod_c, 6, axis=-1)

        h_x = _rmsnorm(x, norm1_g[layer]) * (1.0 + scale1_x) + shift1_x
        h_c = _rmsnorm(ctx, norm1_g[layer]) * (1.0 + scale1_c) + shift1_c
        p_x = h_x @ w_in[layer]
        p_c = h_c @ (w_in[layer] if keep_ctx else w_in[layer][:, :N_STATE_COLS])
        st_x = _state_inputs(p_x[..., :N_STATE_COLS], lower_bounds[layer], ret_log_decay[layer], rope)
        st_c = _state_inputs(p_c[..., :N_STATE_COLS], lower_bounds[layer], ret_log_decay[layer], None)
        rd_x = _read_inputs(p_x[..., N_STATE_COLS:], rope)
        rd_c = _read_inputs(p_c[..., N_STATE_COLS:], None) if keep_ctx else None

        hg_ctx, hg_lat = _prefix_bidirectional_scan(
            None if rd_c is None else rd_c['hg_q'], st_c['hg_k'], st_c['hg_i'], st_c['hg_lf'],
            rd_x['hg_q'], st_x['hg_k'], st_x['hg_i'], st_x['hg_lf'])
        ret_ctx, ret_lat = _prefix_bidirectional_scan(
            None if rd_c is None else rd_c['ret_q'], st_c['ret_k'], st_c['ret_v'], st_c['ret_lf'],
            rd_x['ret_q'], st_x['ret_k'], st_x['ret_v'], st_x['ret_lf'])

        out_x = _mixer_output(hg_lat, ret_lat, rd_x, hg_norm_g[layer], w_branch_hgrn[layer],
                              w_branch_ret[layer], w_out[layer], x.dtype)
        x = x + gate1_x * out_x
        h2_x = _rmsnorm(x, norm2_g[layer]) * (1.0 + scale2_x) + shift2_x
        x = x + gate2_x * _sq_relu_mlp(h2_x, w_ff1[layer], w_ff2[layer])

        if keep_ctx:
            out_c = _mixer_output(hg_ctx, ret_ctx, rd_c, hg_norm_g[layer], w_branch_hgrn[layer],
                                  w_branch_ret[layer], w_out[layer], ctx.dtype)
            ctx = ctx + gate1_c * out_c
            h2_c = _rmsnorm(ctx, norm2_g[layer]) * (1.0 + scale2_c) + shift2_c
            ctx = ctx + gate2_c * _sq_relu_mlp(h2_c, w_ff1[layer], w_ff2[layer])

    return _rmsnorm(x, final_norm_g)
```

```cpp
#include <hip/hip_runtime.h>
#include <cstdio>
#include <cstdint>

namespace pg8 {
#define PG8_LAS __attribute__((address_space(3)))
typedef unsigned short bf16_t;
typedef short bf16x8 __attribute__((ext_vector_type(8)));
typedef float f32x4 __attribute__((ext_vector_type(4)));
typedef unsigned u32x4 __attribute__((ext_vector_type(4)));
constexpr int BM = 256, BK = 64, HALF = 128, HTB = HALF * BK * 2  , STAGE_BYTES = 8 * HTB, NXCD = 8, WGM = 8;

__host__ __device__ __forceinline__ int lds_byte(int r, int c) { const int st = (r >> 4) * 2 + (c >> 5), rr = r & 15, cc = c & 31, ob = rr * 64 + cc * 2; return st * 1024 + (ob ^ (((ob >> 9) & 1) << 5)); }
__host__ __device__ __forceinline__ void stage_rc(int b, int& R, int& C) { const int st = b / 1024, sb = b % 1024, swz = sb ^ (((sb >> 9) & 1) << 5); R = (st >> 1) * 16 + swz / 64; C = (st & 1) * 32 + (swz % 64) / 2; }
__host__ __device__ __forceinline__ int perm32(int rho) { const int n = rho >> 4, i = rho & 15; return 8 * (i >> 2) + 4 * n + (i & 3); }

struct Unit { int pm, pn, am, bn, kind; };
struct Gemm { const bf16_t* A; const bf16_t* Bt; int K; };

struct StaticOrder {
    int nM, nN, nwg, G, c;
    __host__ __device__ void init(int M, int N, int G_, int c_) { nM = M / BM; nN = N / BM; nwg = nM * nN; G = G_; c = c_; }
    __host__ __device__ bool tile(long L, Unit& u) const {
        if (L >= nwg) return false;
        int wgid = (int)L; { const int q = nwg / NXCD, r = nwg % NXCD, xcd = wgid % NXCD, off = wgid / NXCD; wgid = (xcd < r ? xcd * (q + 1) : r * (q + 1) + (xcd - r) * q) + off; }
        const int nig = WGM * nN, gid = wgid / nig, fm = gid * WGM, gsz = (nM - fm) < WGM ? (nM - fm) : WGM;
        u.pm = fm + ((wgid % nig) % gsz); u.pn = (wgid % nig) / gsz; u.am = u.pm; u.bn = u.pn; u.kind = 0; return true;
    }
    __host__ __device__ bool next(int i, Unit& u) const { return tile((long)i * G + c, u); }
};

typedef __bf16 bf16x2_t __attribute__((ext_vector_type(2)));
typedef float f32x2_t __attribute__((ext_vector_type(2)));
__device__ __forceinline__ unsigned cvt_pk_bf16(float lo, float hi) { const f32x2_t f = {lo, hi}; return __builtin_bit_cast(unsigned, __builtin_convertvector(f, bf16x2_t)); }

template <class Epi, class Sched, bool ALIGN_EPI = true>
__device__ __forceinline__ void gemm_phase(PG8_LAS unsigned char* lds, const Gemm g, const Sched& S, const Epi& E) {
    const int tid = threadIdx.x, wid = __builtin_amdgcn_readfirstlane(tid >> 6), lane = tid & 63, wr = wid >> 2, wc = wid & 3, fr = lane & 15, fq = lane >> 4;
    const int K = g.K, nt = K / BK;
    unsigned voffA[2], voffB[2];
#pragma unroll
    for (int i = 0; i < 2; ++i) { int R, C; stage_rc(tid * 16 + i * 8192, R, C); const int Rb = Epi::PERM ? ((R & ~31) + perm32(R & 31)) : R;
        voffA[i] = (unsigned)(R * K + C) * 2u; voffB[i] = (unsigned)(Rb * K + C) * 2u; }
    const size_t kstep = (size_t)(BK * 2);
    const size_t hstep = (size_t)HALF * K * 2;
    const size_t tstep = 2 * hstep;
    const unsigned ldsw = (unsigned)wid * 1024u;
    const int aoff = lds_byte(wr * 64 + fr, fq * 8), boff = lds_byte(wc * 32 + fr, fq * 8);
#define PG8_SA(b, h) (((b) * 2 + (h)) * HTB)
#define PG8_SB(b, h) ((4 + (b) * 2 + (h)) * HTB)
#define PG8_STAGE(bufoff, gbase, voff) do { _Pragma("unroll") for (int _i = 0; _i < 2; ++_i) \
        __builtin_amdgcn_global_load_lds((const unsigned*)((const char*)(gbase) + (voff)[_i]), (PG8_LAS unsigned*)(lds + (bufoff) + ldsw + _i * 8192), 16, 0, 0); } while (0)
#define PG8_LDA(dst, b, h) do { _Pragma("unroll") for (int m = 0; m < 4; ++m) _Pragma("unroll") for (int k = 0; k < 2; ++k) dst[m][k] = *(const PG8_LAS bf16x8*)(lds + PG8_SA(b, h) + aoff + m * 2048 + k * 1024); } while (0)
#define PG8_LDB(dst, b, h) do { _Pragma("unroll") for (int n = 0; n < 2; ++n) _Pragma("unroll") for (int k = 0; k < 2; ++k) dst[n][k] = *(const PG8_LAS bf16x8*)(lds + PG8_SB(b, h) + boff + n * 2048 + k * 1024); } while (0)
#define PG8_MMA(ai, bj, At, Bt) do { __builtin_amdgcn_s_setprio(1); _Pragma("unroll") for (int m = 0; m < 4; ++m) _Pragma("unroll") for (int n = 0; n < 2; ++n) _Pragma("unroll") for (int k = 0; k < 2; ++k) \
        acc[ai][bj][m][n] = __builtin_amdgcn_mfma_f32_16x16x32_bf16(Bt[n][k], At[m][k], acc[ai][bj][m][n], 0, 0, 0); __builtin_amdgcn_s_setprio(0); } while (0)
#define PG8_WAIT_V(n) asm volatile("s_waitcnt vmcnt(" #n ")" ::: "memory")
#define PG8_WAIT_L(n) asm volatile("s_waitcnt lgkmcnt(" #n ")" ::: "memory")
#define PG8_BAR __builtin_amdgcn_s_barrier()
#define PG8_SCHED __builtin_amdgcn_sched_barrier(0)
    Unit cur, nxt; int ui = 0;
    if (!S.next(0, cur)) return;
    f32x4 acc[2][2][4][2];
#pragma unroll
    for (int a = 0; a < 2; ++a)
#pragma unroll
        for (int b = 0; b < 2; ++b)
#pragma unroll
            for (int m = 0; m < 4; ++m)
#pragma unroll
                for (int n = 0; n < 2; ++n) acc[a][b][m][n] = (f32x4){0.f, 0.f, 0.f, 0.f};
    bf16x8 At[4][2], B0[2][2], B1[2][2];
    const char* cA = (const char*)g.A + (size_t)cur.am * tstep; const char* cB = (const char*)g.Bt + (size_t)cur.bn * tstep;
    PG8_STAGE(PG8_SB(0, 0), cB, voffB); PG8_STAGE(PG8_SB(0, 1), cB + hstep, voffB); PG8_STAGE(PG8_SA(0, 0), cA, voffA); PG8_STAGE(PG8_SA(0, 1), cA + hstep, voffA);
    if (wr == 1) PG8_BAR;
    PG8_WAIT_V(2); PG8_BAR;
    PG8_STAGE(PG8_SB(1, 0), cB + kstep, voffB); PG8_STAGE(PG8_SA(1, 0), cA + kstep, voffA); PG8_STAGE(PG8_SB(1, 1), cB + hstep + kstep, voffB);
    PG8_WAIT_V(6); PG8_BAR;
    for (;;) {
        const bool has_next = S.next(ui + 1, nxt);
        const char* nA = has_next ? (const char*)g.A + (size_t)nxt.am * tstep : cA; const char* nB = has_next ? (const char*)g.Bt + (size_t)nxt.bn * tstep : cB;
        for (int t = 0; t < nt; t += 2) {
            const bool last = (t == nt - 2);
            const char* a1 = cA + (size_t)(t + 1) * kstep;
            const char* a2 = last ? nA : cA + (size_t)(t + 2) * kstep; const char* b2 = last ? nB : cB + (size_t)(t + 2) * kstep;
            const char* a3 = a2 + kstep; const char* b3 = b2 + kstep;
            PG8_LDB(B0, 0, 0); PG8_LDB(B1, 0, 1); PG8_SCHED; PG8_LDA(At, 0, 0); PG8_STAGE(PG8_SA(1, 1), a1 + hstep, voffA);
            PG8_WAIT_V(8); PG8_WAIT_L(0); PG8_BAR; PG8_MMA(0, 0, At, B0); PG8_MMA(0, 1, At, B1); PG8_BAR; PG8_SCHED;
            PG8_LDA(At, 0, 1); PG8_STAGE(PG8_SB(0, 0), b2, voffB); PG8_STAGE(PG8_SB(0, 1), b2 + hstep, voffB); PG8_STAGE(PG8_SA(0, 0), a2, voffA);
            PG8_WAIT_V(8); PG8_WAIT_L(0); PG8_BAR; PG8_MMA(1, 0, At, B0); PG8_MMA(1, 1, At, B1); PG8_BAR; PG8_SCHED;
            PG8_LDB(B0, 1, 0); PG8_LDB(B1, 1, 1); PG8_SCHED; PG8_LDA(At, 1, 0); PG8_STAGE(PG8_SA(0, 1), a2 + hstep, voffA);
            PG8_WAIT_V(8); PG8_WAIT_L(0); PG8_BAR; PG8_MMA(0, 0, At, B0); PG8_MMA(0, 1, At, B1); PG8_BAR; PG8_SCHED;
            PG8_LDA(At, 1, 1); PG8_STAGE(PG8_SB(1, 0), b3, voffB); PG8_STAGE(PG8_SB(1, 1), b3 + hstep, voffB); PG8_STAGE(PG8_SA(1, 0), a3, voffA);
            PG8_WAIT_V(8); PG8_WAIT_L(0); PG8_BAR; PG8_MMA(1, 0, At, B0); PG8_MMA(1, 1, At, B1); PG8_BAR; PG8_SCHED;
        }
        if constexpr (ALIGN_EPI) { if (wr == 0) PG8_BAR; }
        const bool reset = E(acc, cur, wr, wc, fr, fq);
        if (!has_next) break;
        if (reset) {
#pragma unroll
            for (int a = 0; a < 2; ++a)
#pragma unroll
                for (int b = 0; b < 2; ++b)
#pragma unroll
                    for (int m = 0; m < 4; ++m)
#pragma unroll
                        for (int n = 0; n < 2; ++n) acc[a][b][m][n] = (f32x4){0.f, 0.f, 0.f, 0.f};
        }
        cur = nxt; cA = nA; cB = nB; ++ui;
        if constexpr (ALIGN_EPI) { if (wr == 1) PG8_BAR; }
    }
    PG8_WAIT_V(0);
    if constexpr (!ALIGN_EPI) { if (wr == 0) PG8_BAR; }
    PG8_BAR;
#undef PG8_SA
#undef PG8_SB
#undef PG8_STAGE
#undef PG8_LDA
#undef PG8_LDB
#undef PG8_MMA
#undef PG8_WAIT_V
#undef PG8_WAIT_L
#undef PG8_BAR
#undef PG8_SCHED
}
}

constexpr int NWAVES = 8;
constexpr int D = 4096, NB = 2, T = 4096, M = NB * T, CT = 256, MC = NB * CT, MA = M + MC;
constexpr int NH = 16, HD = 128, HW = NH * HD, NIN = 26624, NSTATE = 10240, DFF = 16384, NMOD = 6 * D;
constexpr float EPS = 1e-6f;
constexpr int N_PHASES = 11;
#ifndef PROBE_DUP
#define PROBE_DUP -1
#endif
#define DUP(k) for (int rep_ = 0; rep_ < ((PROBE_DUP == (k)) ? 2 : 1); ++rep_)
#ifndef MK_SPLIT
#define MK_SPLIT 0
#endif

constexpr size_t MiB = 1u << 20;
constexpr size_t WS_CTL = 0, CTL_ZERO_BYTES = 1 * MiB;
constexpr size_t WS_MOD = 1 * MiB;
constexpr size_t WS_LB = WS_MOD + 512 * 1024;
constexpr size_t WS_LAM = WS_LB + 64 * 1024;
constexpr size_t WS_COS = 2 * MiB, WS_SIN = 3 * MiB;
constexpr size_t WS_WIN = 4 * MiB;
constexpr size_t WS_WBR = 212 * MiB;
constexpr size_t WS_WO = 244 * MiB;
constexpr size_t WS_WF1 = 276 * MiB;
constexpr size_t WS_WF2 = 404 * MiB;
constexpr size_t WS_ACT = 532 * MiB;
constexpr size_t WS_P = 600 * MiB;
constexpr size_t WS_VH = WS_P + 0 * 32 * MiB, WS_KF = WS_P + 1 * 32 * MiB, WS_LFF = WS_P + 2 * 32 * MiB, WS_KB = WS_P + 3 * 32 * MiB, WS_LFB = WS_P + 4 * 32 * MiB,
                 WS_QH = WS_P + 5 * 32 * MiB, WS_GH = WS_P + 6 * 32 * MiB  , WS_KR = WS_P + 7 * 32 * MiB, WS_VR = WS_P + 8 * 32 * MiB,
                 WS_QR = WS_P + 9 * 32 * MiB, WS_GR = WS_P + 10 * 32 * MiB  ;
constexpr size_t WS_SGH = 952 * MiB, WS_SGR = 1016 * MiB;
constexpr size_t WS_CX = 1080 * MiB;
constexpr size_t WS_FFA = WS_P;
constexpr size_t WS_O = 1094 * MiB;
constexpr size_t WS_Y = 1222 * MiB;
constexpr size_t WS_X1 = 1286 * MiB;
constexpr size_t WS_KRB = 1414 * MiB, WS_QRB = 1446 * MiB;
constexpr size_t WS_EL = 1478 * MiB, WS_ELC = 1480 * MiB;
constexpr size_t WS_END = 1482 * MiB;
static_assert(WS_WIN + (size_t)NIN * D * 2 <= WS_WBR && WS_WF2 + (size_t)D * DFF * 2 <= WS_ACT && WS_ACT + (size_t)MA * D * 2 <= WS_P && WS_GR + 32 * MiB <= WS_SGH && WS_CX + 14 * MiB <= WS_O && WS_FFA + (size_t)M * DFF * 2 <= WS_SGH, "ws map");
constexpr int CW_BAR = 4096;

constexpr int RING_OFF = 0, RING_BYTES = 131072;
constexpr int LDSCTL_OFF = RING_BYTES, MISC_OFF = LDSCTL_OFF + 320;
constexpr int LDS_BYTES = 147456;

#define GAS __attribute__((address_space(1)))
#define LAS __attribute__((address_space(3)))
typedef unsigned short bf16;
typedef unsigned v4u __attribute__((ext_vector_type(4)));
typedef unsigned v2u __attribute__((ext_vector_type(2)));
typedef float f32x4 __attribute__((ext_vector_type(4)));
typedef short bf16x8 __attribute__((ext_vector_type(8)));
typedef short s16x4 __attribute__((ext_vector_type(4)));
typedef GAS unsigned gu32;
#define RLX_AGENT __ATOMIC_RELAXED, __HIP_MEMORY_SCOPE_AGENT
#define LDS_WAIT() asm volatile("s_waitcnt lgkmcnt(0)" ::: "memory")
#define VM_WAIT() asm volatile("s_waitcnt vmcnt(0)" ::: "memory")
__device__ __forceinline__ unsigned f2bf(float f) { unsigned u = __builtin_bit_cast(unsigned, f); return (u + 0x7fffu + ((u >> 16) & 1u)) >> 16; }
__device__ __forceinline__ unsigned pk2(float lo, float hi) { return f2bf(lo) | (f2bf(hi) << 16); }
__device__ __forceinline__ float bf2f(unsigned b) { return __builtin_bit_cast(float, b << 16); }
__device__ __forceinline__ float bflo(unsigned w) { return __builtin_bit_cast(float, w << 16); }
__device__ __forceinline__ float bfhi(unsigned w) { return __builtin_bit_cast(float, w & 0xffff0000u); }
__device__ __forceinline__ unsigned f2h(float f) { const _Float16 h = (_Float16)f; return (unsigned)__builtin_bit_cast(unsigned short, h); }
__device__ __forceinline__ float h2f(unsigned h) { return (float)__builtin_bit_cast(_Float16, (unsigned short)h); }
__device__ __forceinline__ float sigmoidf_(float x) { return __builtin_amdgcn_rcpf(1.0f + __expf(-x)); }

#define XB_TMO      128
#define XB_XCNT(j)  (256  + 64 * (j))
#define XB_XSUB(j)  (1280 + 64 * (j))
#define XB_XGEN(j)  (2304 + 64 * (j))
#define XB_TOP      3328
#define XB_TOPGEN   3392
#define XCD_BAR_WORDS 3456
#define XB_SPIN_CAP (1u << 18)

__device__ __forceinline__ unsigned xb_ld(unsigned* p)              { return __hip_atomic_load(p, __ATOMIC_RELAXED, __HIP_MEMORY_SCOPE_AGENT); }
__device__ __forceinline__ unsigned xb_add(unsigned* p, unsigned v) { return __hip_atomic_fetch_add(p, v, __ATOMIC_RELAXED, __HIP_MEMORY_SCOPE_AGENT); }
__device__ __forceinline__ unsigned xb_xcc_id() { return (unsigned)__builtin_amdgcn_s_getreg((3 << 11) | 20) & 0xFu; }
#define XB_SPIN(cond, bar) do { unsigned _sp = 0; while (cond) { __builtin_amdgcn_s_sleep(1); \
    if ((++_sp & 255u) == 0u) { if (xb_ld(&(bar)[XB_TMO])) break; if (_sp > XB_SPIN_CAP) { atomicAdd(&(bar)[XB_TMO], 1u); break; } } } } while (0)

struct XcdBarrier {
    unsigned* bar; unsigned x;
    volatile LAS unsigned* st;
};
__device__ __forceinline__ XcdBarrier xcd_barrier_post(unsigned* bar, volatile LAS unsigned* st) {
    XcdBarrier b; b.bar = bar; b.x = xb_xcc_id(); b.st = st;
    if (threadIdx.x == 0) (void)xb_add(&bar[XB_XCNT(b.x)], 1u);
    return b;
}
__device__ __forceinline__ void xcd_barrier_complete(unsigned* bar, unsigned x, unsigned& nloc, unsigned& nx) {
    const unsigned G = gridDim.x * gridDim.y * gridDim.z;
    unsigned sum, cnt, mine, sp = 0u;
    for (;;) {
        sum = 0u; cnt = 0u; mine = 0u;
#pragma unroll
        for (unsigned j = 0; j < 16; ++j) { const unsigned c = xb_ld(&bar[XB_XCNT(j)]); sum += c; cnt += (c > 0u) ? 1u : 0u; mine = (j == x) ? c : mine; }
        if (sum == G) break;
        __builtin_amdgcn_s_sleep(1);
        if ((++sp & 255u) == 0u) { if (xb_ld(&bar[XB_TMO])) break; if (sp > XB_SPIN_CAP) { atomicAdd(&bar[XB_TMO], 1u); break; } }
    }
    nloc = mine > 0u ? mine : 1u; nx = cnt > 0u ? cnt : 1u;
}
__device__ __forceinline__ void xcd_barrier(const XcdBarrier& b) {
    asm volatile("s_waitcnt vmcnt(0)" ::: "memory");
    __syncthreads();
    if (threadIdx.x == 0) {
        unsigned* bar = b.bar;
        __builtin_amdgcn_s_waitcnt(0);
        unsigned nloc = b.st[0], nx = b.st[1];
        if (nloc == 0u) { xcd_barrier_complete(bar, b.x, nloc, nx); b.st[0] = nloc; b.st[1] = nx; }
        const unsigned old = xb_add(&bar[XB_XSUB(b.x)], 1u);
        const unsigned gen = old / nloc;
        if (old + 1u == (gen + 1u) * nloc) {
            __builtin_amdgcn_fence(__ATOMIC_RELEASE, "agent");
            asm volatile("s_waitcnt vmcnt(0)" ::: "memory");
            const unsigned og = xb_add(&bar[XB_TOP], 1u);
            const unsigned tg = og / nx;
            if (og + 1u == (tg + 1u) * nx) xb_add(&bar[XB_TOPGEN], 1u);
            else XB_SPIN(xb_ld(&bar[XB_TOPGEN]) == tg, bar);
            __builtin_amdgcn_fence(__ATOMIC_ACQUIRE, "agent");
            xb_add(&bar[XB_XGEN(b.x)], 1u);
            asm volatile("s_waitcnt vmcnt(0)" ::: "memory");
        } else {
            XB_SPIN(xb_ld(&bar[XB_XGEN(b.x)]) == gen, bar);
            __builtin_amdgcn_fence(__ATOMIC_ACQUIRE, "agent");
            asm volatile("s_waitcnt vmcnt(0)" ::: "memory");
        }
    }
    __syncthreads();
}

struct Frame {
    LAS unsigned char* lds;
    volatile LAS unsigned* MISC;
    gu32* ctl;
    int tid, lane, wave, G;
    const float* in[18];
    float* out;
    unsigned char* ws;
};
__device__ __forceinline__ float wave_sum(float v) {
#pragma unroll
    for (int o = 1; o < 64; o <<= 1) v += __shfl_xor(v, o);
    return v;
}

__device__ __forceinline__ void p0_transpose_item(const float* W, int N, bf16* WT, int ldk, int row_off, LAS float* scr, int item, int lane) {
    const int nblk = N / 32, kb = item / nblk, nb = item % nblk, k0 = 64 * kb, n0 = 32 * nb;
#pragma unroll 8
    for (int i = 0; i < 32; ++i) { const int kk = 2 * i + (lane >> 5); scr[kk * 33 + (lane & 31)] = W[(size_t)(k0 + kk) * N + n0 + (lane & 31)]; }
    LDS_WAIT(); asm volatile("" ::: "memory");
    const int c = lane & 7;
#pragma unroll
    for (int j = 0; j < 4; ++j) { const int n = (lane >> 3) + 8 * j; const LAS float* s = scr + (8 * c) * 33 + n;
        v4u o; o.x = pk2(s[0 * 33], s[1 * 33]); o.y = pk2(s[2 * 33], s[3 * 33]); o.z = pk2(s[4 * 33], s[5 * 33]); o.w = pk2(s[6 * 33], s[7 * 33]);
        *(GAS v4u*)(WT + (size_t)(row_off + n0 + n) * ldk + k0 + 8 * c) = o; }
    LDS_WAIT(); asm volatile("" ::: "memory");
}
__device__ __forceinline__ void p0_prologue(Frame& F) {
    const float* const (&in)[18] = F.in;
    unsigned char* ws = F.ws;
    const int gt = blockIdx.x * 512 + F.tid, GT = F.G * 512;
    { float* LB = (float*)(ws + WS_LB); const float* lg = in[9];
      for (int i = gt; i < 2 * HW; i += GT) { const float l0 = lg[i], l1 = lg[2 * HW + i]; LB[i] = 1.f / (1.f + expf(l1 - l0)); } }
    if (gt < 2 * NH) ((float*)(ws + WS_LAM))[gt] = -log1pf(expf(-in[11][gt]));
    { float* COS = (float*)(ws + WS_COS); float* SIN = (float*)(ws + WS_SIN);
      for (int i = gt; i < T * 64; i += GT) { const int t = i >> 6, j = i & 63, fi = j & 31; const int pos = (j < 32) ? (t >> 6) : (t & 63);
          const float inv = powf(10000.0f, -(float)fi / 32.0f); const float ang = (float)pos * inv; float s, c; sincosf(ang, &s, &c); COS[i] = c; SIN[i] = s; } }
    {
        LAS float* sv = (LAS float*)(F.lds);
        LAS float* red = (LAS float*)(F.lds + 49152);
        for (int i = F.tid; i < 3 * D; i += 512) { const int v = i / D, k = i % D; const float x = (v < 2) ? in[1][v * D + k] : in[3][k]; sv[i] = x / (1.0f + expf(-x)); }
        __syncthreads();
        float* MOD = (float*)(ws + WS_MOD);
        for (int item = blockIdx.x; item < NMOD / 96; item += F.G) {
            const int ks = F.tid / 24, cg = F.tid % 24;
            if (F.tid < 504) {
                f32x4 a0 = {0.f, 0.f, 0.f, 0.f}, a1 = a0, a2 = a0;
                const float* wp = in[4] + 96 * item + 4 * cg;
#pragma unroll 8
                for (int k = ks; k < D; k += 21) { const f32x4 w = *(const GAS f32x4*)(wp + (size_t)k * NMOD); a0 += w * sv[k]; a1 += w * sv[D + k]; a2 += w * sv[2 * D + k]; }
#pragma unroll
                for (int j = 0; j < 4; ++j) { red[(ks * 3 + 0) * 96 + 4 * cg + j] = a0[j]; red[(ks * 3 + 1) * 96 + 4 * cg + j] = a1[j]; red[(ks * 3 + 2) * 96 + 4 * cg + j] = a2[j]; }
            }
            __syncthreads();
            if (F.tid < 288) { const int v = F.tid / 96, n = F.tid % 96; float s = 0.f;
                for (int q = 0; q < 21; ++q) s += red[(q * 3 + v) * 96 + n];
                MOD[v * NMOD + 96 * item + n] = s + in[5][96 * item + n]; }
            __syncthreads();
        }
    }
    {
        LAS float* scr = (LAS float*)(F.lds + F.wave * 16384);
        const int gw = blockIdx.x * NWAVES + F.wave, NGW = F.G * NWAVES;
        constexpr int I_IN = (D / 64) * (NIN / 32), I_BR = (HW / 64) * (D / 32), I_O = (D / 64) * (D / 32), I_1 = (D / 64) * (DFF / 32), I_2 = (DFF / 64) * (D / 32);
        constexpr int NITEMS = I_IN + 2 * I_BR + I_O + I_1 + I_2;
        bf16* WIN = (bf16*)(ws + WS_WIN); bf16* WBR = (bf16*)(ws + WS_WBR); bf16* WO = (bf16*)(ws + WS_WO); bf16* WF1 = (bf16*)(ws + WS_WF1); bf16* WF2 = (bf16*)(ws + WS_WF2);
        for (int it = gw; it < NITEMS; it += NGW) {
            int r = it;
            if (r < I_IN) { p0_transpose_item(in[8], NIN, WIN, D, 0, scr, r, F.lane); continue; } r -= I_IN;
            if (r < I_BR) { p0_transpose_item(in[12], D, WBR, HW, 0, scr, r, F.lane); continue; } r -= I_BR;
            if (r < I_BR) { p0_transpose_item(in[13], D, WBR, HW, D, scr, r, F.lane); continue; } r -= I_BR;
            if (r < I_O) { p0_transpose_item(in[14], D, WO, D, 0, scr, r, F.lane); continue; } r -= I_O;
            if (r < I_1) { p0_transpose_item(in[15], DFF, WF1, D, 0, scr, r, F.lane); continue; } r -= I_1;
            p0_transpose_item(in[16], D, WF2, DFF, 0, scr, r, F.lane);
        }
    }
}

__device__ __forceinline__ void rms_mod_row(int lane, const float* xrow, const float* g, const float* shift, const float* scale, bf16* orow) {
    const GAS f32x4* xr = (const GAS f32x4*)xrow + lane;
    f32x4 v[16]; float s = 0.f;
#pragma unroll
    for (int j = 0; j < 16; ++j) { v[j] = xr[64 * j]; s += (v[j].x * v[j].x + v[j].y * v[j].y) + (v[j].z * v[j].z + v[j].w * v[j].w); }
    const float rstd = 1.0f / sqrtf(wave_sum(s) * (1.0f / D) + EPS);
    const GAS f32x4* g4 = (const GAS f32x4*)g + lane; const GAS f32x4* sh4 = (const GAS f32x4*)shift + lane; const GAS f32x4* sc4 = (const GAS f32x4*)scale + lane;
    GAS v2u* o8 = (GAS v2u*)orow + lane;
#pragma unroll
    for (int j = 0; j < 16; ++j) { const f32x4 gg = g4[64 * j], sh = sh4[64 * j], sc = sc4[64 * j];
        const f32x4 o = v[j] * rstd * gg * (sc + 1.0f) + sh;
        v2u w; w.x = pk2(o.x, o.y); w.y = pk2(o.z, o.w); o8[64 * j] = w; }
}
__device__ __forceinline__ void rms_final_row(int lane, float* row, const float* g) {
    GAS f32x4* xr = (GAS f32x4*)row + lane;
    f32x4 v[16]; float s = 0.f;
#pragma unroll
    for (int j = 0; j < 16; ++j) { v[j] = xr[64 * j]; s += (v[j].x * v[j].x + v[j].y * v[j].y) + (v[j].z * v[j].z + v[j].w * v[j].w); }
    const float rstd = 1.0f / sqrtf(wave_sum(s) * (1.0f / D) + EPS);
    const GAS f32x4* g4 = (const GAS f32x4*)g + lane;
#pragma unroll
    for (int j = 0; j < 16; ++j) xr[64 * j] = v[j] * rstd * g4[64 * j];
}

template <int N> __device__ __forceinline__ float dpp_shr(float v) { return __builtin_bit_cast(float, __builtin_amdgcn_update_dpp(0, __builtin_bit_cast(int, v), 0x110 + N, 0xf, 0xf, false)); }
__device__ __forceinline__ float row_scan16(float v) { v += dpp_shr<1>(v); v += dpp_shr<2>(v); v += dpp_shr<4>(v); v += dpp_shr<8>(v); return v; }
template <int N> __device__ __forceinline__ float dpp_ror(float v) { return __builtin_bit_cast(float, __builtin_amdgcn_update_dpp(0, __builtin_bit_cast(int, v), 0x120 + N, 0xf, 0xf, false)); }
__device__ __forceinline__ float row_sum16(float v) { v += dpp_ror<8>(v); v += dpp_ror<4>(v); v += dpp_ror<2>(v); v += dpp_ror<1>(v); return v; }
struct EpiIn {
    static constexpr bool PERM = true;
    unsigned char* ws; const float* rlogit;
    template <int SEC>
    __device__ __forceinline__ void run(pg8::f32x4 (&acc)[2][2][4][2], const pg8::Unit& u, int ts, int wr, int wc, int fr, int fq) const {
        const bool isctx = u.pm >= 32;
        const int b = isctx ? (u.pm - 32) : (u.pm >> 4);
        const int tbase = isctx ? 0 : (u.pm & 15) * 256;
        const int Tlen = isctx ? CT : T;
        const int j0 = wc * 32 + 8 * fq;
        const float RS = 0.08838834764831845f;
        if constexpr (SEC == 1 || SEC == 2) {
            constexpr int d = SEC - 1;
            const int j0_ = j0, fr_ = fr;
#pragma unroll
            for (int ai = 0; ai < 2; ++ai) {
                const int chunk = isctx ? (2 * ai + wr) : ((u.pm & 15) * 4 + 2 * ai + wr);
#pragma unroll
                for (int bj = 0; bj < 2; ++bj) {
                    const int hd = 2 * ts + bj;
#pragma unroll
                    for (int n = 0; n < 2; ++n) {
                        int j0 = j0_, fr = fr_; asm volatile("" : "+v"(j0), "+v"(fr));
                        const f32x4 lbv = *(const GAS f32x4*)((const float*)(ws + WS_LB) + d * HW + hd * HD + j0 + 4 * n);
                        unsigned kpk[4][2], epk[4][2]; float kprev[4], eprev[4], total[4];
#pragma unroll
                        for (int e = 0; e < 4; ++e) {
                            float run = 0.f, kk[4], cx[4]; const float om = 1.0f - lbv[e];
#pragma unroll
                            for (int m = 0; m < 4; ++m) { const float z = acc[ai][bj][m][n][e]; const float ez = __builtin_amdgcn_exp2f(z * -1.44269504f), sg = __builtin_amdgcn_rcpf(1.0f + ez);
                                kk[m] = om * ez * sg;
                                const float lf = __builtin_amdgcn_logf(lbv[e] + om * sg);
                                const float p = row_scan16(lf); const float t = row_sum16(lf);
                                cx[m] = d ? (p + run - lf) : (p + run); run += t; }
                            total[e] = run;
#pragma unroll
                            for (int m = 0; m < 4; ++m) { const float c = d ? (run - cx[m]) : cx[m]; const float ke = kk[m] * __builtin_amdgcn_exp2f(-c), ee = __builtin_amdgcn_exp2f(c);
                                if (e & 1) { kpk[m][e >> 1] = pg8::cvt_pk_bf16(kprev[m], ke); epk[m][e >> 1] = pg8::cvt_pk_bf16(eprev[m], ee); } else { kprev[m] = ke; eprev[m] = ee; } }
                            __builtin_amdgcn_sched_barrier(0);
                        }
                        if (fr == 0) { const f32x4 et = {__builtin_amdgcn_exp2f(total[0]), __builtin_amdgcn_exp2f(total[1]), __builtin_amdgcn_exp2f(total[2]), __builtin_amdgcn_exp2f(total[3])};
                            float* elp = isctx ? (float*)(ws + WS_ELC) + ((size_t)((d * NB + b) * NH + hd) * (CT / 64) + chunk) * HD : (float*)(ws + WS_EL) + ((size_t)((d * NB + b) * NH + hd) * (T / 64) + chunk) * HD;
                            *(GAS f32x4*)(elp + j0 + 4 * n) = et; }
#pragma unroll
                        for (int m = 0; m < 4; ++m) {
                            const int t = tbase + ai * 128 + wr * 64 + m * 16 + fr;
                            const size_t hoff = ((size_t)(b * NH + hd) * Tlen + t) * HD + j0 + 4 * n;
                            bf16* dk = (bf16*)(ws + (isctx ? (WS_CX + (d == 0 ? 1 : 3) * 2 * MiB) : (d == 0 ? WS_KF : WS_KB))) + hoff;
                            v2u w2; w2.x = kpk[m][0]; w2.y = kpk[m][1];
                            *(GAS v2u*)dk = w2;
                            if (!isctx) { bf16* de = (bf16*)(ws + (d == 0 ? WS_LFF : WS_LFB)) + hoff;
                                v2u x2; x2.x = epk[m][0]; x2.y = epk[m][1];
                                *(GAS v2u*)de = x2; }
                        }
                        __builtin_amdgcn_sched_barrier(0);
                    }
                }
            }
            return;
        }
#pragma unroll
        for (int ai = 0; ai < 2; ++ai)
#pragma unroll
            for (int m = 0; m < 4; ++m) {
                const int tl = ai * 128 + wr * 64 + m * 16 + fr, t = tbase + tl;
                const int r = u.pm * 256 + tl;
#pragma unroll
                for (int bj = 0; bj < 2; ++bj) {
                    const pg8::f32x4 v0 = acc[ai][bj][m][0], v1 = acc[ai][bj][m][1];
                    float v[8] = {v0[0], v0[1], v0[2], v0[3], v1[0], v1[1], v1[2], v1[3]};
                    const int hd = 2 * ts + bj;
                    const size_t hoff = ((size_t)(b * NH + hd) * Tlen + t) * HD + j0;
                    if constexpr (SEC == 0 || SEC == 4) {
                        bf16* dst = (bf16*)(ws + (isctx ? (WS_CX + (SEC == 0 ? 0 : 6) * 2 * MiB) : (SEC == 0 ? WS_VH : WS_VR))) + hoff;
                        v4u w; w.x = pg8::cvt_pk_bf16(v[0], v[1]); w.y = pg8::cvt_pk_bf16(v[2], v[3]); w.z = pg8::cvt_pk_bf16(v[4], v[5]); w.w = pg8::cvt_pk_bf16(v[6], v[7]);
                        *(GAS v4u*)dst = w;
                    } else if constexpr (SEC == 3 || SEC == 7) {
                        if constexpr (SEC == 3) {
#pragma unroll
                            for (int e = 0; e < 8; ++e) v[e] *= RS;
                        }
                        if (!isctx) {
                            const f32x4 cs = *(const GAS f32x4*)((const float*)(ws + WS_COS) + t * 64 + (j0 >> 1));
                            const f32x4 sn = *(const GAS f32x4*)((const float*)(ws + WS_SIN) + t * 64 + (j0 >> 1));
#pragma unroll
                            for (int p = 0; p < 4; ++p) { const float a1 = v[2 * p], a2 = v[2 * p + 1]; v[2 * p] = a1 * cs[p] - a2 * sn[p]; v[2 * p + 1] = a1 * sn[p] + a2 * cs[p]; }
                        }
                        const float lamf = ((const float*)(ws + WS_LAM))[hd], lamb = ((const float*)(ws + WS_LAM))[NH + hd];
                        const int pos = m * 16 + fr;
                        const float cf = (float)(pos + 1) * lamf, cb = (float)(64 - pos) * lamb;
                        const float sf = __expf(SEC == 3 ? -cf : cf), sb = __expf(SEC == 3 ? -cb : cb);
                        bf16* dstf = (bf16*)(ws + (SEC == 3 ? (isctx ? (WS_CX + 5 * 2 * MiB) : WS_KR) : WS_QR)) + hoff;
                        bf16* dstb = (bf16*)(ws + (SEC == 3 ? (isctx ? (WS_CX + 2 * 2 * MiB) : WS_KRB) : WS_QRB)) + hoff;
                        v4u w; w.x = pg8::cvt_pk_bf16(v[0] * sf, v[1] * sf); w.y = pg8::cvt_pk_bf16(v[2] * sf, v[3] * sf); w.z = pg8::cvt_pk_bf16(v[4] * sf, v[5] * sf); w.w = pg8::cvt_pk_bf16(v[6] * sf, v[7] * sf);
                        *(GAS v4u*)dstf = w;
                        v4u x; x.x = pg8::cvt_pk_bf16(v[0] * sb, v[1] * sb); x.y = pg8::cvt_pk_bf16(v[2] * sb, v[3] * sb); x.z = pg8::cvt_pk_bf16(v[4] * sb, v[5] * sb); x.w = pg8::cvt_pk_bf16(v[6] * sb, v[7] * sb);
                        *(GAS v4u*)dstb = x;
                    } else if constexpr (SEC == 5) {
#pragma unroll
                        for (int e = 0; e < 8; ++e) v[e] = v[e] * sigmoidf_(v[e]) * RS;
                        bf16* dst = (bf16*)(ws + WS_QH) + hoff;
                        v4u w; w.x = pg8::cvt_pk_bf16(v[0], v[1]); w.y = pg8::cvt_pk_bf16(v[2], v[3]); w.z = pg8::cvt_pk_bf16(v[4], v[5]); w.w = pg8::cvt_pk_bf16(v[6], v[7]);
                        *(GAS v4u*)dst = w;
                    } else if constexpr (SEC == 6 || SEC == 8) {
#pragma unroll
                        for (int e = 0; e < 8; ++e) v[e] = v[e] * sigmoidf_(v[e]);
                        bf16* dst = (bf16*)(ws + (SEC == 6 ? WS_GH : WS_GR)) + (size_t)r * HW + hd * HD + j0;
                        v4u w; w.x = pg8::cvt_pk_bf16(v[0], v[1]); w.y = pg8::cvt_pk_bf16(v[2], v[3]); w.z = pg8::cvt_pk_bf16(v[4], v[5]); w.w = pg8::cvt_pk_bf16(v[6], v[7]);
                        *(GAS v4u*)dst = w;
                    } else {
#pragma unroll
                        for (int e = 0; e < 8; ++e) v[e] = sigmoidf_(v[e]);
                        bf16* dst = (bf16*)(ws + (SEC == 9 ? WS_SGH : WS_SGR)) + (size_t)r * D + ts * 256 + bj * 128 + j0;
                        v4u w; w.x = pg8::cvt_pk_bf16(v[0], v[1]); w.y = pg8::cvt_pk_bf16(v[2], v[3]); w.z = pg8::cvt_pk_bf16(v[4], v[5]); w.w = pg8::cvt_pk_bf16(v[6], v[7]);
                        *(GAS v4u*)dst = w;
                    }
                }
            }
    }
    __device__ __forceinline__ bool operator()(pg8::f32x4 (&acc)[2][2][4][2], const pg8::Unit& u, int wr, int wc, int fr, int fq) const {
        { int ln; asm volatile("v_mbcnt_lo_u32_b32 %0, -1, 0\n\tv_mbcnt_hi_u32_b32 %0, -1, %0" : "=v"(ln)); fr = ln & 15; fq = ln >> 4; }
        asm volatile("" : "+s"(wr), "+s"(wc));
        const int pn = u.pn;
        if (pn < 72) { const int sec = pn >> 3, ts = pn & 7;
            switch (sec) {
                case 0: run<0>(acc, u, ts, wr, wc, fr, fq); break;
                case 1: run<1>(acc, u, ts, wr, wc, fr, fq); break;
                case 2: run<2>(acc, u, ts, wr, wc, fr, fq); break;
                case 3: run<3>(acc, u, ts, wr, wc, fr, fq); break;
                case 4: run<4>(acc, u, ts, wr, wc, fr, fq); break;
                case 5: run<5>(acc, u, ts, wr, wc, fr, fq); break;
                case 6: run<6>(acc, u, ts, wr, wc, fr, fq); break;
                case 7: run<7>(acc, u, ts, wr, wc, fr, fq); break;
                default: run<8>(acc, u, ts, wr, wc, fr, fq); break;
            }
        } else if (pn < 88) run<9>(acc, u, pn - 72, wr, wc, fr, fq);
        else run<10>(acc, u, pn - 88, wr, wc, fr, fq);
        return true;
    }
};
struct InOrder {
    pg8::StaticOrder so;
    __device__ void init(int G, int c) { so.init(M, NIN, G, c); }
    __device__ bool next(int i, pg8::Unit& u) const {
        const long L = (long)i * so.G + so.c;
        if (L < so.nwg) return so.tile(L, u);
        const int j = (int)(L - so.nwg); if (j >= 2 * (NSTATE / 256)) return false;
        u.pm = 32 + (j & 1); u.pn = j >> 1; u.am = u.pm; u.bn = u.pn; u.kind = 0; return true;
    }
};
struct EpiMerge {
    static constexpr bool PERM = true;
    const bf16* SGH; const bf16* SGR; bf16* OUT;
    __device__ __forceinline__ bool operator()(pg8::f32x4 (&acc)[2][2][4][2], const pg8::Unit& u, int wr, int wc, int fr, int fq) const {
        const int row0 = u.pm * 256 + wr * 64 + fr, col0 = u.pn * 256 + wc * 32 + 8 * fq;
#pragma unroll
        for (int ai = 0; ai < 2; ++ai)
#pragma unroll
            for (int m = 0; m < 4; ++m) {
                const size_t ro = (size_t)(row0 + ai * 128 + m * 16) * D + col0;
#pragma unroll
                for (int bj = 0; bj < 2; ++bj) {
                    const v4u gr = *(const GAS v4u*)(SGR + ro + bj * 128);
                    float sr[8] = {bflo(gr.x), bfhi(gr.x), bflo(gr.y), bfhi(gr.y), bflo(gr.z), bfhi(gr.z), bflo(gr.w), bfhi(gr.w)};
#pragma unroll
                    for (int e = 0; e < 8; ++e) sr[e] = fmaxf(sr[e], 1e-30f);
                    if (u.kind == 0) {
                        const v4u gh = *(const GAS v4u*)(SGH + ro + bj * 128);
                        const float sh[8] = {bflo(gh.x), bfhi(gh.x), bflo(gh.y), bfhi(gh.y), bflo(gh.z), bfhi(gh.z), bflo(gh.w), bfhi(gh.w)};
#pragma unroll
                        for (int e = 0; e < 4; ++e) { acc[ai][bj][m][0][e] *= sh[e] / sr[e]; acc[ai][bj][m][1][e] *= sh[4 + e] / sr[4 + e]; }
                    } else {
                        const pg8::f32x4 v0 = acc[ai][bj][m][0], v1 = acc[ai][bj][m][1];
                        v4u w; w.x = pg8::cvt_pk_bf16(v0[0] * sr[0], v0[1] * sr[1]); w.y = pg8::cvt_pk_bf16(v0[2] * sr[2], v0[3] * sr[3]);
                        w.z = pg8::cvt_pk_bf16(v1[0] * sr[4], v1[1] * sr[5]); w.w = pg8::cvt_pk_bf16(v1[2] * sr[6], v1[3] * sr[7]);
                        *(GAS v4u*)(OUT + ro + bj * 128) = w;
                    }
                }
            }
        return u.kind != 0;
    }
};
struct MergeOrder {
    pg8::StaticOrder so;
    __device__ void init(int G, int c) { so.init(M, D, G, c); }
    __device__ bool next(int i, pg8::Unit& u) const {
        if (!so.next(i >> 1, u)) return false;
        u.kind = i & 1; u.am = u.pm + u.kind * (M / 256); u.bn = u.pn + u.kind * (D / 256); return true;
    }
};
struct EpiResGate {
    static constexpr bool PERM = false;
    const float* base; const float* gate  ; float* out;
    __device__ __forceinline__ bool operator()(pg8::f32x4 (&acc)[2][2][4][2], const pg8::Unit& u, int wr, int wc, int fr, int fq) const {
        const int row0 = u.pm * 256 + wr * 64 + fr, col0 = u.pn * 256 + wc * 32 + 4 * fq;
        const float* gp = gate + (size_t)(u.pm >> 4) * NMOD + col0;
        f32x4 gv[2][2];
#pragma unroll
        for (int bj = 0; bj < 2; ++bj)
#pragma unroll
            for (int n = 0; n < 2; ++n) gv[bj][n] = *(const GAS f32x4*)(gp + bj * 128 + n * 16);
#pragma unroll
        for (int ai = 0; ai < 2; ++ai)
#pragma unroll
            for (int m = 0; m < 4; ++m) { const size_t ro = (size_t)(row0 + ai * 128 + m * 16) * D + col0;
#pragma unroll
                for (int bj = 0; bj < 2; ++bj)
#pragma unroll
                    for (int n = 0; n < 2; ++n) { const f32x4 bs = *(const GAS f32x4*)(base + ro + bj * 128 + n * 16);
                        *(GAS f32x4*)(out + ro + bj * 128 + n * 16) = bs + gv[bj][n] * acc[ai][bj][m][n]; }
                asm volatile("" ::: "memory"); }
        return true;
    }
};
struct EpiRelu2 {
    static constexpr bool PERM = true;
    bf16* O;
    __device__ __forceinline__ bool operator()(pg8::f32x4 (&acc)[2][2][4][2], const pg8::Unit& u, int wr, int wc, int fr, int fq) const {
        const int row0 = u.pm * 256 + wr * 64 + fr, col0 = u.pn * 256 + wc * 32 + 8 * fq;
#pragma unroll
        for (int ai = 0; ai < 2; ++ai)
#pragma unroll
            for (int m = 0; m < 4; ++m) { bf16* rowp = O + (size_t)(row0 + ai * 128 + m * 16) * DFF + col0;
#pragma unroll
                for (int bj = 0; bj < 2; ++bj) { pg8::f32x4 v0 = acc[ai][bj][m][0], v1 = acc[ai][bj][m][1];
#pragma unroll
                    for (int e = 0; e < 4; ++e) { const float a = fmaxf(v0[e], 0.f), c = fmaxf(v1[e], 0.f); v0[e] = a * a; v1[e] = c * c; }
                    v4u w; w.x = pg8::cvt_pk_bf16(v0[0], v0[1]); w.y = pg8::cvt_pk_bf16(v0[2], v0[3]); w.z = pg8::cvt_pk_bf16(v1[0], v1[1]); w.w = pg8::cvt_pk_bf16(v1[2], v1[3]);
                    *(GAS v4u*)(rowp + bj * 128) = w; } }
        return true;
    }
};

constexpr int SC_QE = 0, SC_KE = 16384, SC_VV = 32768, SC_ST = 49152, SC_EL = 49152 + 2 * 17408, SC_END = SC_EL + 512;
static_assert(SC_END <= RING_BYTES, "scan LDS");
__device__ __forceinline__ unsigned off_b(unsigned row, unsigned ch) { return 256u * row + 16u * (ch ^ (((row & 3u) << 2) | ((row >> 2) & 3u))); }
__device__ __forceinline__ s16x4 tr_rd(LAS unsigned char* p) { return __builtin_amdgcn_ds_read_tr16_b64_v4i16((LAS s16x4*)p); }
__device__ __forceinline__ void scan_mfma(LAS unsigned char* L, LAS bf16* STc, LAS bf16* STn, LAS float* EL, bf16* Og, bool isc, int dir, size_t tok0_, int h, int vh, int w, int c16, int g, int qq, int pp, int tt, int vp, f32x4 (&accS)[4]) {
        if (!isc) {
            bf16x8 Qf[4];
#pragma unroll
            for (int ks = 0; ks < 4; ++ks) Qf[ks] = *(const LAS bf16x8*)(L + SC_QE + off_b(16 * tt + c16, 4 * ks + g));
            f32x4 sc[4];
#pragma unroll
            for (int a = 0; a < 4; ++a) { sc[a] = (f32x4){0.f, 0.f, 0.f, 0.f};
#pragma unroll
                for (int ks = 0; ks < 4; ++ks) { const bf16x8 Af = *(const LAS bf16x8*)(L + SC_KE + off_b(16 * a + c16, 4 * ks + g));
                    sc[a] = __builtin_amdgcn_mfma_f32_16x16x32_bf16(Af, Qf[ks], sc[a], 0, 0, 0); }
                const int tcol = 16 * tt + c16;
#pragma unroll
                for (int i = 0; i < 4; ++i) { const int sidx = 16 * a + 4 * g + i; const bool keep = dir ? (sidx >= tcol) : (sidx <= tcol); sc[a][i] = keep ? sc[a][i] : 0.f; }
            }
            bf16x8 Pf[2];
#pragma unroll
            for (int kp = 0; kp < 2; ++kp) { v4u p; p.x = pg8::cvt_pk_bf16(sc[2 * kp][0], sc[2 * kp][1]); p.y = pg8::cvt_pk_bf16(sc[2 * kp][2], sc[2 * kp][3]);
                p.z = pg8::cvt_pk_bf16(sc[2 * kp + 1][0], sc[2 * kp + 1][1]); p.w = pg8::cvt_pk_bf16(sc[2 * kp + 1][2], sc[2 * kp + 1][3]);
                Pf[kp] = __builtin_bit_cast(bf16x8, p); }
            const size_t tok0 = tok0_;
#pragma unroll
            for (int q2 = 0; q2 < 2; ++q2) { const int vt = 2 * vp + q2;
                f32x4 o = {0.f, 0.f, 0.f, 0.f};
#pragma unroll
                for (int ks = 0; ks < 4; ++ks) { const bf16x8 Af = *(const LAS bf16x8*)(STc + (16 * vt + c16) * 136 + 32 * ks + 8 * g);
                    o = __builtin_amdgcn_mfma_f32_16x16x32_bf16(Af, Qf[ks], o, 0, 0, 0); }
#pragma unroll
                for (int kp = 0; kp < 2; ++kp) {
                    const s16x4 lo = tr_rd(L + SC_VV + off_b(32 * kp + 4 * g + qq, 2 * (4 * vh + vt) + (pp >> 1)) + 8 * (pp & 1));
                    const s16x4 hi = tr_rd(L + SC_VV + off_b(32 * kp + 16 + 4 * g + qq, 2 * (4 * vh + vt) + (pp >> 1)) + 8 * (pp & 1));
                    const bf16x8 Af = __builtin_shufflevector(lo, hi, 0, 1, 2, 3, 4, 5, 6, 7);
                    o = __builtin_amdgcn_mfma_f32_16x16x32_bf16(Af, Pf[kp], o, 0, 0, 0); }
                v2u ow; ow.x = pg8::cvt_pk_bf16(o[0], o[1]); ow.y = pg8::cvt_pk_bf16(o[2], o[3]);
                *(GAS v2u*)(Og + (tok0 + 16 * tt + c16) * HW + h * HD + vh * 64 + 16 * vt + 4 * g) = ow;
            }
        }
        {
            bf16x8 Kf[2];
#pragma unroll
            for (int kp = 0; kp < 2; ++kp) {
                const s16x4 lo = tr_rd(L + SC_KE + off_b(32 * kp + 8 * g + qq, 2 * w + (pp >> 1)) + 8 * (pp & 1));
                const s16x4 hi = tr_rd(L + SC_KE + off_b(32 * kp + 8 * g + 4 + qq, 2 * w + (pp >> 1)) + 8 * (pp & 1));
                Kf[kp] = __builtin_shufflevector(lo, hi, 0, 1, 2, 3, 4, 5, 6, 7); }
            const f32x4 el = *(const LAS f32x4*)(EL + 16 * w + 4 * g);
#pragma unroll
            for (int vt = 0; vt < 4; ++vt) {
#pragma unroll
                for (int kp = 0; kp < 2; ++kp) {
                    const s16x4 lo = tr_rd(L + SC_VV + off_b(32 * kp + 8 * g + qq, 2 * (4 * vh + vt) + (pp >> 1)) + 8 * (pp & 1));
                    const s16x4 hi = tr_rd(L + SC_VV + off_b(32 * kp + 8 * g + 4 + qq, 2 * (4 * vh + vt) + (pp >> 1)) + 8 * (pp & 1));
                    const bf16x8 Bf = __builtin_shufflevector(lo, hi, 0, 1, 2, 3, 4, 5, 6, 7);
                    accS[vt] = __builtin_amdgcn_mfma_f32_16x16x32_bf16(Kf[kp], Bf, accS[vt], 0, 0, 0); }
                accS[vt] = accS[vt] * el;
                v2u sw; sw.x = pg8::cvt_pk_bf16(accS[vt][0], accS[vt][1]); sw.y = pg8::cvt_pk_bf16(accS[vt][2], accS[vt][3]);
                *(LAS v2u*)(STn + (16 * vt + c16) * 136 + 16 * w + 4 * g) = sw;
            }
        }
}
__device__ __forceinline__ void scan_unit(Frame& F, int unit) {
    const int tid = F.tid, lane = F.lane, w = F.wave;
    const int vh = (unit >> 3) & 1, dir = (unit >> 4) & 1, rest = (unit & 7) | ((unit >> 5) << 3);
    const int br = rest & 1, b = (rest >> 1) & 1, h = rest >> 2;
    unsigned char* ws = F.ws;
    const bf16* Qg = (const bf16*)(ws + (br ? (dir ? WS_QRB : WS_QR) : WS_QH));
    const bf16* Eg = (const bf16*)(ws + (dir ? WS_LFB : WS_LFF));
    const bf16* Kg = (const bf16*)(ws + (br ? (dir ? WS_KRB : WS_KR) : (dir ? WS_KB : WS_KF)));
    const bf16* Vg = (const bf16*)(ws + (br ? WS_VR : WS_VH));
    const bf16* Kc = (const bf16*)(ws + WS_CX + (size_t)(br ? (dir ? 2 : 5) : (dir ? 3 : 1)) * 2 * MiB);
    const bf16* Vc = (const bf16*)(ws + WS_CX + (size_t)(br ? 6 : 0) * 2 * MiB);
    const float* ELg = (const float*)(ws + WS_EL) + (size_t)((dir * NB + b) * NH + h) * (T / 64) * HD;
    const float* ELc = (const float*)(ws + WS_ELC) + (size_t)((dir * NB + b) * NH + h) * (CT / 64) * HD;
    bf16* Og = (bf16*)(ws + WS_O + (size_t)(br * 2 + dir) * 32 * MiB);
    float elr = 1.f;
    if (br) elr = __expf(64.0f * ((const float*)(ws + WS_LAM))[dir * NH + h]);
    LAS unsigned char* L = F.lds + RING_OFF;
    LAS bf16* ST = (LAS bf16*)(L + SC_ST); LAS float* EL = (LAS float*)(L + SC_EL);
    f32x4 accS[4];
#pragma unroll
    for (int i = 0; i < 4; ++i) accS[i] = (f32x4){0.f, 0.f, 0.f, 0.f};
    const int c16 = lane & 15, g = lane >> 4, qq = c16 >> 2, pp = c16 & 3;
    const int tt = w & 3, vp = w >> 2;
    const unsigned lo0 = off_b((unsigned)tid >> 4, (unsigned)tid & 15), lo1 = off_b(((unsigned)tid >> 4) + 32, (unsigned)tid & 15);
    const unsigned lov = off_b((unsigned)tid >> 3, (unsigned)(vh * 8 + (tid & 7)));
    v4u rq0A, rq1A, re0A, re1A, rk0A, rk1A, rvA, rq0B, rq1B, re0B, re1B, rk0B, rk1B, rvB; float relA = 1.f, relB = 1.f;
    rq0A = rq1A = re0A = re1A = rq0B = rq1B = re0B = re1B = (v4u){0u, 0u, 0u, 0u};
    constexpr int NSTEP = 4 + T / 64;
    static_assert(NSTEP % 2 == 0, "the step loop is unrolled by two");
#define SCAN_LOAD(step_, X) do { const int st_ = (step_); const bool isc_ = st_ < 4; const int ci_ = isc_ ? (dir ? 3 - st_ : st_) : (dir ? (T / 64 - 1) - (st_ - 4) : (st_ - 4)); \
        const size_t tb_ = isc_ ? ((size_t)(b * NH + h) * CT + 64 * ci_) * HD : ((size_t)(b * NH + h) * T + 64 * ci_) * HD; \
        const GAS v4u* kp_ = (const GAS v4u*)((isc_ ? Kc : Kg) + tb_) + tid; rk0##X = kp_[0]; rk1##X = kp_[512]; \
        rv##X = *(const GAS v4u*)((isc_ ? Vc : Vg) + tb_ + (size_t)(tid >> 3) * HD + vh * 64 + (tid & 7) * 8); \
        if (!isc_) { const GAS v4u* qp_ = (const GAS v4u*)(Qg + tb_) + tid; rq0##X = qp_[0]; rq1##X = qp_[512]; \
            if (!br) { const GAS v4u* ep_ = (const GAS v4u*)(Eg + tb_) + tid; re0##X = ep_[0]; re1##X = ep_[512]; } } \
        if (!br && tid < HD) rel##X = (isc_ ? ELc : ELg)[ci_ * HD + tid]; } while (0)
#define MULQE(q_, e_) pg8::cvt_pk_bf16(bflo(q_) * bflo(e_), bfhi(q_) * bfhi(e_))
#define SCAN_STEP(step_, X) do { const int step = (step_); \
        const bool isc = step < 4; \
        const int ci = isc ? (dir ? 3 - step : step) : (dir ? (T / 64 - 1) - (step - 4) : (step - 4)); \
          \
        __syncthreads();                                     \
        *(LAS v4u*)(L + SC_KE + lo0) = rk0##X; *(LAS v4u*)(L + SC_KE + lo1) = rk1##X; \
        *(LAS v4u*)(L + SC_VV + lov) = rv##X; \
        if (!isc) { \
            if (!br) { v4u a, c2; \
                a.x = MULQE(rq0##X.x, re0##X.x); a.y = MULQE(rq0##X.y, re0##X.y); a.z = MULQE(rq0##X.z, re0##X.z); a.w = MULQE(rq0##X.w, re0##X.w); \
                c2.x = MULQE(rq1##X.x, re1##X.x); c2.y = MULQE(rq1##X.y, re1##X.y); c2.z = MULQE(rq1##X.z, re1##X.z); c2.w = MULQE(rq1##X.w, re1##X.w); \
                *(LAS v4u*)(L + SC_QE + lo0) = a; *(LAS v4u*)(L + SC_QE + lo1) = c2; \
            } else { *(LAS v4u*)(L + SC_QE + lo0) = rq0##X; *(LAS v4u*)(L + SC_QE + lo1) = rq1##X; } \
        } \
        if (tid < HD) EL[tid] = br ? elr : rel##X; \
        __syncthreads(); \
        if (step + 2 < NSTEP) SCAN_LOAD(step + 2, X); \
        LAS bf16* STc = ST + (step & 1) * (64 * 136); LAS bf16* STn = ST + ((step + 1) & 1) * (64 * 136); \
        scan_mfma(L, STc, STn, EL, Og, isc, dir, (size_t)b * T + 64 * ci, h, vh, w, c16, g, qq, pp, tt, vp, accS); } while (0)
    SCAN_LOAD(0, A); SCAN_LOAD(1, B);
    for (int step2 = 0; step2 < NSTEP; step2 += 2) { SCAN_STEP(step2, A); SCAN_STEP(step2 + 1, B); }
#undef SCAN_STEP
#undef SCAN_LOAD
#undef MULQE
    __syncthreads();
}

__device__ __forceinline__ void p4_combine(Frame& F) {
    unsigned char* ws = F.ws;
    const int gw = blockIdx.x * NWAVES + F.wave, NGW = F.G * NWAVES;
    const int sub = F.lane >> 4, l16 = F.lane & 15;
    const float* gain = F.in[10];
    const f32x4 ga = *(const GAS f32x4*)(gain + 8 * l16), gb = *(const GAS f32x4*)(gain + 8 * l16 + 4);
    const float gn[8] = {ga[0], ga[1], ga[2], ga[3], gb[0], gb[1], gb[2], gb[3]};
    constexpr int NIT = 2 * M * NH / 4;
    for (int it = gw; it < NIT; it += NGW) {
        const int idx = it * 4 + sub;
        const int br = idx / (M * NH), th = idx % (M * NH);
        const size_t eo = (size_t)th * HD + 8 * l16;
        const v4u a = *(const GAS v4u*)((const bf16*)(ws + WS_O + (size_t)(br * 2 + 0) * 32 * MiB) + eo);
        const v4u c = *(const GAS v4u*)((const bf16*)(ws + WS_O + (size_t)(br * 2 + 1) * 32 * MiB) + eo);
        const v4u gg = *(const GAS v4u*)((const bf16*)(ws + (br ? WS_GR : WS_GH)) + eo);
        float o[8] = {bflo(a.x) + bflo(c.x), bfhi(a.x) + bfhi(c.x), bflo(a.y) + bflo(c.y), bfhi(a.y) + bfhi(c.y), bflo(a.z) + bflo(c.z), bfhi(a.z) + bfhi(c.z), bflo(a.w) + bflo(c.w), bfhi(a.w) + bfhi(c.w)};
        const float gt[8] = {bflo(gg.x), bfhi(gg.x), bflo(gg.y), bfhi(gg.y), bflo(gg.z), bfhi(gg.z), bflo(gg.w), bfhi(gg.w)};
        float s = 0.f;
#pragma unroll
        for (int e = 0; e < 8; ++e) s += o[e];
#pragma unroll
        for (int d = 1; d < 16; d <<= 1) s += __shfl_xor(s, d);
        const float mu = br ? s * (1.0f / HD) : 0.f;
        float q = 0.f;
#pragma unroll
        for (int e = 0; e < 8; ++e) { o[e] -= mu; q += o[e] * o[e]; }
#pragma unroll
        for (int d = 1; d < 16; d <<= 1) q += __shfl_xor(q, d);
        const float rstd = 1.0f / sqrtf(q * (1.0f / HD) + EPS);
        float y[8];
#pragma unroll
        for (int e = 0; e < 8; ++e) y[e] = o[e] * rstd * (br ? 1.0f : gn[e]) * gt[e];
        v4u wv; wv.x = pk2(y[0], y[1]); wv.y = pk2(y[2], y[3]); wv.z = pk2(y[4], y[5]); wv.w = pk2(y[6], y[7]);
        *(GAS v4u*)((bf16*)(ws + WS_Y + (size_t)br * 32 * MiB) + eo) = wv;
    }
}

struct Args { const float* in[18]; float* out; unsigned char* ws; int ph_lo, ph_hi; };
__global__ void __launch_bounds__(NWAVES * 64, 2) fwd_kernel(Args args) {
    extern __shared__ __attribute__((aligned(16))) unsigned char lds[];
    Frame F;
    F.lds = (LAS unsigned char*)lds;
    F.MISC = (volatile LAS unsigned*)(F.lds + MISC_OFF);
    F.tid = threadIdx.x; F.lane = F.tid & 63; F.wave = __builtin_amdgcn_readfirstlane(F.tid >> 6);
    F.G = gridDim.x;
#pragma unroll
    for (int i = 0; i < 18; ++i) F.in[i] = args.in[i];
    F.out = args.out; F.ws = args.ws;
    unsigned char* ws = args.ws;
    F.ctl = (gu32*)(ws + WS_CTL);
    for (int u = F.tid; u < (LDS_BYTES - LDSCTL_OFF) / 4; u += NWAVES * 64) ((LAS unsigned*)(F.lds + LDSCTL_OFF))[u] = 0u;
    __syncthreads();
    XcdBarrier bar; bar.bar = (unsigned*)(F.ctl + CW_BAR); bar.x = 0; bar.st = nullptr;
    if (!MK_SPLIT) bar = xcd_barrier_post((unsigned*)(F.ctl + CW_BAR), F.MISC + 8);
    const int lo = args.ph_lo, hi = args.ph_hi;
#define IN(k) (lo <= (k) && (k) < hi)
#define SEAM(k) do { if (IN(k) && IN((k) + 1)) xcd_barrier(bar); } while (0)
    const int gw = blockIdx.x * NWAVES + F.wave, NGW = F.G * NWAVES;
    float* MOD = (float*)(ws + WS_MOD);

    if (IN(0)) { _Pragma("unroll") DUP(0) { p0_prologue(F); __syncthreads(); } }
    SEAM(0);
    F.tid = threadIdx.x; asm volatile("" : "+v"(F.tid)); F.lane = F.tid & 63;
    if (IN(1)) {
        bf16* ACT = (bf16*)(ws + WS_ACT);
        for (int r = gw; r < MA; r += NGW) {
            const bool isx = r < M; const int mv = isx ? (r / T) : 2;
            const float* xrow = isx ? args.in[0] + (size_t)r * D : args.in[2] + (size_t)(r - M) * D;
            rms_mod_row(F.lane, xrow, args.in[6], MOD + (size_t)mv * NMOD + 0 * D, MOD + (size_t)mv * NMOD + 1 * D, ACT + (size_t)r * D);
        }
    }
    SEAM(1);
    if (IN(2)) {
        pg8::Gemm g{(const bf16*)(ws + WS_ACT), (const bf16*)(ws + WS_WIN), D}; InOrder S; S.init(F.G, (int)blockIdx.x);
        EpiIn E{ws, args.in[11]};
        _Pragma("unroll") DUP(2) { pg8::gemm_phase<EpiIn, InOrder>(F.lds + RING_OFF, g, S, E); }
    }
    SEAM(2);
    F.tid = threadIdx.x; asm volatile("" : "+v"(F.tid)); F.lane = F.tid & 63;
    if (IN(3)) { _Pragma("unroll") DUP(3) { for (int u = blockIdx.x; u < 256; u += F.G) scan_unit(F, u); } }
    SEAM(3);
    F.tid = threadIdx.x; asm volatile("" : "+v"(F.tid)); F.lane = F.tid & 63;
    if (IN(4)) { p4_combine(F); }
    SEAM(4);
    if (IN(5)) {
        pg8::Gemm g{(const bf16*)(ws + WS_Y), (const bf16*)(ws + WS_WBR), HW}; MergeOrder S; S.init(F.G, (int)blockIdx.x);
        EpiMerge E{(const bf16*)(ws + WS_SGH), (const bf16*)(ws + WS_SGR), (bf16*)(ws + WS_ACT)};
        pg8::gemm_phase<EpiMerge, MergeOrder>(F.lds + RING_OFF, g, S, E);
    }
    SEAM(5);
    if (IN(6)) {
        pg8::Gemm g{(const bf16*)(ws + WS_ACT), (const bf16*)(ws + WS_WO), D}; pg8::StaticOrder S; S.init(M, D, F.G, (int)blockIdx.x);
        EpiResGate E{args.in[0], MOD + 2 * D, (float*)(ws + WS_X1)};
        pg8::gemm_phase<EpiResGate, pg8::StaticOrder>(F.lds + RING_OFF, g, S, E);
    }
    SEAM(6);
    F.tid = threadIdx.x; asm volatile("" : "+v"(F.tid)); F.lane = F.tid & 63;
    if (IN(7)) {
        bf16* ACT = (bf16*)(ws + WS_ACT); const float* X1 = (const float*)(ws + WS_X1);
        for (int r = gw; r < M; r += NGW) { const int mv = r / T;
            rms_mod_row(F.lane, X1 + (size_t)r * D, args.in[7], MOD + (size_t)mv * NMOD + 3 * D, MOD + (size_t)mv * NMOD + 4 * D, ACT + (size_t)r * D); }
    }
    SEAM(7);
    if (IN(8)) {
        pg8::Gemm g{(const bf16*)(ws + WS_ACT), (const bf16*)(ws + WS_WF1), D}; pg8::StaticOrder S; S.init(M, DFF, F.G, (int)blockIdx.x);
        EpiRelu2 E{(bf16*)(ws + WS_FFA)};
        _Pragma("unroll") DUP(8) { pg8::gemm_phase<EpiRelu2, pg8::StaticOrder>(F.lds + RING_OFF, g, S, E); }
    }
    SEAM(8);
    if (IN(9)) {
        pg8::Gemm g{(const bf16*)(ws + WS_FFA), (const bf16*)(ws + WS_WF2), DFF}; pg8::StaticOrder S; S.init(M, D, F.G, (int)blockIdx.x);
        EpiResGate E{(const float*)(ws + WS_X1), MOD + 5 * D, args.out};
        pg8::gemm_phase<EpiResGate, pg8::StaticOrder>(F.lds + RING_OFF, g, S, E);
    }
    SEAM(9);
    F.tid = threadIdx.x; asm volatile("" : "+v"(F.tid)); F.lane = F.tid & 63;
    if (IN(10)) {
        for (int r = gw; r < M; r += NGW) rms_final_row(F.lane, args.out + (size_t)r * D, args.in[17]);
    }
#undef IN
#undef SEAM
}

extern "C" void kernel_launch(void* const* d_in, const int* in_sizes, int n_in, void* d_out, int out_size, void* d_ws, size_t ws_size, hipStream_t stream) {
    static int grid = 0;
    if (grid == 0) {
        if (n_in != 18 || in_sizes[0] != M * D || out_size != M * D || ws_size < WS_END) { fprintf(stderr, "kernel_launch: unexpected shapes / workspace (%d inputs, in0 %d, out %d, ws %zu < %zu)\n", n_in, n_in > 0 ? in_sizes[0] : -1, out_size, ws_size, (size_t)WS_END); grid = -1; return; }
        int dev = 0, cus = 0, per_cu = 0;
        if (hipGetDevice(&dev) != hipSuccess || hipDeviceGetAttribute(&cus, hipDeviceAttributeMultiprocessorCount, dev) != hipSuccess) { grid = -1; return; }
        if (hipFuncSetAttribute((const void*)fwd_kernel, hipFuncAttributeMaxDynamicSharedMemorySize, LDS_BYTES) != hipSuccess) { fprintf(stderr, "kernel_launch: hipFuncSetAttribute failed\n"); grid = -1; return; }
        if (hipOccupancyMaxActiveBlocksPerMultiprocessor(&per_cu, (const void*)fwd_kernel, NWAVES * 64, LDS_BYTES) != hipSuccess || per_cu < 1)
            fprintf(stderr, "kernel_launch: note: occupancy query reports %d workgroups per CU\n", per_cu);
        (void)hipGetLastError();
        grid = cus;
    }
    if (grid < 0) return;
    if (hipMemsetAsync((char*)d_ws + WS_CTL, 0, CTL_ZERO_BYTES, stream) != hipSuccess) return;
    Args a{};
    for (int i = 0; i < 18; ++i) a.in[i] = (const float*)d_in[i];
    a.out = (float*)d_out; a.ws = (unsigned char*)d_ws;
#if MK_SPLIT
    for (int p = 0; p < N_PHASES; ++p) { a.ph_lo = p; a.ph_hi = p + 1; hipLaunchKernelGGL(fwd_kernel, dim3(grid), dim3(NWAVES * 64), LDS_BYTES, stream, a); }
#else
    a.ph_lo = 0; a.ph_hi = N_PHASES;
    hipLaunchKernelGGL(fwd_kernel, dim3(grid), dim3(NWAVES * 64), LDS_BYTES, stream, a);
#endif
    const hipError_t le = hipPeekAtLastError();
    if (le != hipSuccess) fprintf(stderr, "kernel_launch: launch failed: %s\n", hipGetErrorName(le));
}
```

```cpp
#include <hip/hip_runtime.h>
#include <cstdio>
#include <cstdint>

namespace pg8 {
#define PG8_LAS __attribute__((address_space(3)))
typedef unsigned short bf16_t;
typedef short bf16x8 __attribute__((ext_vector_type(8)));
typedef float f32x4 __attribute__((ext_vector_type(4)));
typedef unsigned u32x4 __attribute__((ext_vector_type(4)));
constexpr int BM = 256, BK = 64, HALF = 128, HTB = HALF * BK * 2  , STAGE_BYTES = 8 * HTB, NXCD = 8, WGM = 8;

__host__ __device__ __forceinline__ int lds_byte(int r, int c) { const int st = (r >> 4) * 2 + (c >> 5), rr = r & 15, cc = c & 31, ob = rr * 64 + cc * 2; return st * 1024 + (ob ^ (((ob >> 9) & 1) << 5)); }
__host__ __device__ __forceinline__ void stage_rc(int b, int& R, int& C) { const int st = b / 1024, sb = b % 1024, swz = sb ^ (((sb >> 9) & 1) << 5); R = (st >> 1) * 16 + swz / 64; C = (st & 1) * 32 + (swz % 64) / 2; }
__host__ __device__ __forceinline__ int perm32(int rho) { const int n = rho >> 4, i = rho & 15; return 8 * (i >> 2) + 4 * n + (i & 3); }

__device__ __forceinline__ int lane_now() { int ln; asm volatile("v_mbcnt_lo_u32_b32 %0, -1, 0\n\tv_mbcnt_hi_u32_b32 %0, -1, %0" : "=v"(ln)); return ln; }
struct Unit { int pm, pn, am, bn, kind; };
struct Gemm { const bf16_t* A; const bf16_t* Bt; int K; };

struct StaticOrder {
    int nM, nN, nwg, G, c;
    __host__ __device__ void init(int M, int N, int G_, int c_) { nM = M / BM; nN = N / BM; nwg = nM * nN; G = G_; c = c_; }
    __host__ __device__ bool tile(long L, Unit& u) const {
        if (L >= nwg) return false;
        int wgid = (int)L; { const int q = nwg / NXCD, r = nwg % NXCD, xcd = wgid % NXCD, off = wgid / NXCD; wgid = (xcd < r ? xcd * (q + 1) : r * (q + 1) + (xcd - r) * q) + off; }
        const int nig = WGM * nN, gid = wgid / nig, fm = gid * WGM, gsz = (nM - fm) < WGM ? (nM - fm) : WGM;
        u.pm = fm + ((wgid % nig) % gsz); u.pn = (wgid % nig) / gsz; u.am = u.pm; u.bn = u.pn; u.kind = 0; return true;
    }
    __host__ __device__ bool next(int i, Unit& u) const { return tile((long)i * G + c, u); }
};

typedef __bf16 bf16x2_t __attribute__((ext_vector_type(2)));
typedef float f32x2_t __attribute__((ext_vector_type(2)));
__device__ __forceinline__ unsigned cvt_pk_bf16(float lo, float hi) { const f32x2_t f = {lo, hi}; return __builtin_bit_cast(unsigned, __builtin_convertvector(f, bf16x2_t)); }

template <class Epi, class Sched, bool ALIGN_EPI = true>
__device__ __forceinline__ void gemm_phase(PG8_LAS unsigned char* lds, const Gemm g, const Sched& S, const Epi& E, int wid_in) {
    const int wid = __builtin_amdgcn_readfirstlane(wid_in), lane = lane_now(), tid = wid * 64 + lane, wr = wid >> 2, wc = wid & 3, fr = lane & 15, fq = lane >> 4;
    const int K = g.K, nt = K / BK;
    unsigned voffA[2], voffB[2];
#pragma unroll
    for (int i = 0; i < 2; ++i) { int R, C; stage_rc(tid * 16 + i * 8192, R, C); const int Rb = Epi::PERM ? ((R & ~31) + perm32(R & 31)) : R;
        voffA[i] = (unsigned)(R * K + C) * 2u; voffB[i] = (unsigned)(Rb * K + C) * 2u; }
    const size_t kstep = (size_t)(BK * 2);
    const size_t hstep = (size_t)HALF * K * 2;
    const size_t tstep = 2 * hstep;
    const unsigned ldsw = (unsigned)wid * 1024u;
    const int aoff = lds_byte(wr * 64 + fr, fq * 8), boff = lds_byte(wc * 32 + fr, fq * 8);
#define PG8_SA(b, h) (((b) * 2 + (h)) * HTB)
#define PG8_SB(b, h) ((4 + (b) * 2 + (h)) * HTB)
#define PG8_STAGE(bufoff, gbase, voff) do { _Pragma("unroll") for (int _i = 0; _i < 2; ++_i) \
        __builtin_amdgcn_global_load_lds((const unsigned*)((const char*)(gbase) + (voff)[_i]), (PG8_LAS unsigned*)(lds + (bufoff) + ldsw + _i * 8192), 16, 0, 0); } while (0)
#define PG8_LDA(dst, b, h) do { _Pragma("unroll") for (int m = 0; m < 4; ++m) _Pragma("unroll") for (int k = 0; k < 2; ++k) dst[m][k] = *(const PG8_LAS bf16x8*)(lds + PG8_SA(b, h) + aoff + m * 2048 + k * 1024); } while (0)
#define PG8_LDB(dst, b, h) do { _Pragma("unroll") for (int n = 0; n < 2; ++n) _Pragma("unroll") for (int k = 0; k < 2; ++k) dst[n][k] = *(const PG8_LAS bf16x8*)(lds + PG8_SB(b, h) + boff + n * 2048 + k * 1024); } while (0)
#define PG8_MMA(ai, bj, At, Bt) do { __builtin_amdgcn_s_setprio(1); _Pragma("unroll") for (int m = 0; m < 4; ++m) _Pragma("unroll") for (int n = 0; n < 2; ++n) _Pragma("unroll") for (int k = 0; k < 2; ++k) \
        acc[ai][bj][m][n] = __builtin_amdgcn_mfma_f32_16x16x32_bf16(Bt[n][k], At[m][k], acc[ai][bj][m][n], 0, 0, 0); __builtin_amdgcn_s_setprio(0); } while (0)
#define PG8_WAIT_V(n) asm volatile("s_waitcnt vmcnt(" #n ")" ::: "memory")
#define PG8_WAIT_L(n) asm volatile("s_waitcnt lgkmcnt(" #n ")" ::: "memory")
#define PG8_BAR __builtin_amdgcn_s_barrier()
#define PG8_SCHED __builtin_amdgcn_sched_barrier(0)
    Unit cur, nxt; int ui = 0;
    if (!S.next(0, cur)) return;
    f32x4 acc[2][2][4][2];
#pragma unroll
    for (int a = 0; a < 2; ++a)
#pragma unroll
        for (int b = 0; b < 2; ++b)
#pragma unroll
            for (int m = 0; m < 4; ++m)
#pragma unroll
                for (int n = 0; n < 2; ++n) acc[a][b][m][n] = (f32x4){0.f, 0.f, 0.f, 0.f};
    bf16x8 At[4][2], B0[2][2], B1[2][2];
    const char* cA = (const char*)g.A + (size_t)cur.am * tstep; const char* cB = (const char*)g.Bt + (size_t)cur.bn * tstep;
    PG8_STAGE(PG8_SB(0, 0), cB, voffB); PG8_STAGE(PG8_SB(0, 1), cB + hstep, voffB); PG8_STAGE(PG8_SA(0, 0), cA, voffA); PG8_STAGE(PG8_SA(0, 1), cA + hstep, voffA);
    if (wr == 1) PG8_BAR;
    PG8_WAIT_V(2); PG8_BAR;
    PG8_STAGE(PG8_SB(1, 0), cB + kstep, voffB); PG8_STAGE(PG8_SA(1, 0), cA + kstep, voffA); PG8_STAGE(PG8_SB(1, 1), cB + hstep + kstep, voffB);
    PG8_WAIT_V(6); PG8_BAR;
    for (;;) {
        const bool has_next = S.next(ui + 1, nxt);
        const char* nA = has_next ? (const char*)g.A + (size_t)nxt.am * tstep : cA; const char* nB = has_next ? (const char*)g.Bt + (size_t)nxt.bn * tstep : cB;
        for (int t = 0; t < nt; t += 2) {
            const bool last = (t == nt - 2);
            const char* a1 = cA + (size_t)(t + 1) * kstep;
            const char* a2 = last ? nA : cA + (size_t)(t + 2) * kstep; const char* b2 = last ? nB : cB + (size_t)(t + 2) * kstep;
            const char* a3 = a2 + kstep; const char* b3 = b2 + kstep;
            PG8_LDB(B0, 0, 0); PG8_LDB(B1, 0, 1); PG8_SCHED; PG8_LDA(At, 0, 0); PG8_STAGE(PG8_SA(1, 1), a1 + hstep, voffA);
            PG8_WAIT_V(8); PG8_WAIT_L(0); PG8_BAR; PG8_MMA(0, 0, At, B0); PG8_MMA(0, 1, At, B1); PG8_BAR; PG8_SCHED;
            PG8_LDA(At, 0, 1); PG8_STAGE(PG8_SB(0, 0), b2, voffB); PG8_STAGE(PG8_SB(0, 1), b2 + hstep, voffB); PG8_STAGE(PG8_SA(0, 0), a2, voffA);
            PG8_WAIT_V(8); PG8_WAIT_L(0); PG8_BAR; PG8_MMA(1, 0, At, B0); PG8_MMA(1, 1, At, B1); PG8_BAR; PG8_SCHED;
            PG8_LDB(B0, 1, 0); PG8_LDB(B1, 1, 1); PG8_SCHED; PG8_LDA(At, 1, 0); PG8_STAGE(PG8_SA(0, 1), a2 + hstep, voffA);
            PG8_WAIT_V(8); PG8_WAIT_L(0); PG8_BAR; PG8_MMA(0, 0, At, B0); PG8_MMA(0, 1, At, B1); PG8_BAR; PG8_SCHED;
            PG8_LDA(At, 1, 1); PG8_STAGE(PG8_SB(1, 0), b3, voffB); PG8_STAGE(PG8_SB(1, 1), b3 + hstep, voffB); PG8_STAGE(PG8_SA(1, 0), a3, voffA);
            PG8_WAIT_V(8); PG8_WAIT_L(0); PG8_BAR; PG8_MMA(1, 0, At, B0); PG8_MMA(1, 1, At, B1); PG8_BAR; PG8_SCHED;
        }
        if constexpr (ALIGN_EPI) { if (wr == 0) PG8_BAR; }
        const bool reset = E(acc, cur, wr, wc, 0, 0);
        if (!has_next) break;
        if (reset) {
#pragma unroll
            for (int a = 0; a < 2; ++a)
#pragma unroll
                for (int b = 0; b < 2; ++b)
#pragma unroll
                    for (int m = 0; m < 4; ++m)
#pragma unroll
                        for (int n = 0; n < 2; ++n) acc[a][b][m][n] = (f32x4){0.f, 0.f, 0.f, 0.f};
        }
        cur = nxt; cA = nA; cB = nB; ++ui;
        if constexpr (ALIGN_EPI) { if (wr == 1) PG8_BAR; }
    }
    PG8_WAIT_V(0);
    if constexpr (!ALIGN_EPI) { if (wr == 0) PG8_BAR; }
    PG8_BAR;
#undef PG8_SA
#undef PG8_SB
#undef PG8_STAGE
#undef PG8_LDA
#undef PG8_LDB
#undef PG8_MMA
#undef PG8_WAIT_V
#undef PG8_WAIT_L
#undef PG8_BAR
#undef PG8_SCHED
}
}

constexpr int NWAVES = 8;
constexpr int D = 4096, NB = 2, T = 4096, M = NB * T, CT = 256, MC = NB * CT, MA = M + MC;
constexpr int NH = 16, HD = 128, HW = NH * HD, NIN = 26624, NSTATE = 10240, DFF = 16384, NMOD = 6 * D;
constexpr float EPS = 1e-6f;
constexpr int N_PHASES = 11;
#ifndef PROBE_DUP
#define PROBE_DUP -1
#endif
#define DUP(k) for (int rep_ = 0; rep_ < ((PROBE_DUP == (k)) ? 2 : 1); ++rep_)
#ifndef MK_SPLIT
#define MK_SPLIT 0
#endif

constexpr size_t MiB = 1u << 20;
constexpr size_t WS_CTL = 0, CTL_ZERO_BYTES = 1 * MiB;
constexpr size_t WS_MOD = 1 * MiB;
constexpr size_t WS_LB = WS_MOD + 512 * 1024;
constexpr size_t WS_LAM = WS_LB + 64 * 1024;
constexpr size_t WS_COS = 2 * MiB, WS_SIN = 3 * MiB;
constexpr size_t WS_WIN = 4 * MiB;
constexpr size_t WS_WBR = 212 * MiB;
constexpr size_t WS_WO = 244 * MiB;
constexpr size_t WS_WF1 = 276 * MiB;
constexpr size_t WS_WF2 = 404 * MiB;
constexpr size_t WS_ACT = 532 * MiB;
constexpr size_t WS_P = 600 * MiB;
constexpr size_t WS_VH = WS_P + 0 * 32 * MiB, WS_KF = WS_P + 1 * 32 * MiB, WS_LFF = WS_P + 2 * 32 * MiB, WS_KB = WS_P + 3 * 32 * MiB, WS_LFB = WS_P + 4 * 32 * MiB,
                 WS_QH = WS_P + 5 * 32 * MiB, WS_GH = WS_P + 6 * 32 * MiB  , WS_KR = WS_P + 7 * 32 * MiB, WS_VR = WS_P + 8 * 32 * MiB,
                 WS_QR = WS_P + 9 * 32 * MiB, WS_GR = WS_P + 10 * 32 * MiB  ;
constexpr size_t WS_SGH = 952 * MiB, WS_SGR = 1016 * MiB;
constexpr size_t WS_CX = 1080 * MiB;
constexpr size_t WS_FFA = WS_P;
constexpr size_t WS_O = 1094 * MiB;
constexpr size_t WS_Y = 1222 * MiB;
constexpr size_t WS_X1 = 1286 * MiB;
constexpr size_t WS_KRB = 1414 * MiB, WS_QRB = 1446 * MiB;
constexpr size_t WS_EL = 1478 * MiB, WS_ELC = 1480 * MiB;
constexpr size_t WS_END = 1482 * MiB;
static_assert(WS_WIN + (size_t)NIN * D * 2 <= WS_WBR && WS_WF2 + (size_t)D * DFF * 2 <= WS_ACT && WS_ACT + (size_t)MA * D * 2 <= WS_P && WS_GR + 32 * MiB <= WS_SGH && WS_CX + 14 * MiB <= WS_O && WS_FFA + (size_t)M * DFF * 2 <= WS_SGH, "ws map");
constexpr int CW_BAR = 4096;

constexpr int RING_OFF = 0, RING_BYTES = 131072;
constexpr int LDSCTL_OFF = RING_BYTES, MISC_OFF = LDSCTL_OFF + 320;
constexpr int LDS_BYTES = 147456;

#define GAS __attribute__((address_space(1)))
#define LAS __attribute__((address_space(3)))
typedef unsigned short bf16;
typedef unsigned v4u __attribute__((ext_vector_type(4)));
typedef unsigned v2u __attribute__((ext_vector_type(2)));
typedef float f32x4 __attribute__((ext_vector_type(4)));
typedef short bf16x8 __attribute__((ext_vector_type(8)));
typedef short s16x4 __attribute__((ext_vector_type(4)));
typedef GAS unsigned gu32;
#define RLX_AGENT __ATOMIC_RELAXED, __HIP_MEMORY_SCOPE_AGENT
#define LDS_WAIT() asm volatile("s_waitcnt lgkmcnt(0)" ::: "memory")
#define VM_WAIT() asm volatile("s_waitcnt vmcnt(0)" ::: "memory")
__device__ __forceinline__ unsigned f2bf(float f) { unsigned u = __builtin_bit_cast(unsigned, f); return (u + 0x7fffu + ((u >> 16) & 1u)) >> 16; }
__device__ __forceinline__ unsigned pk2(float lo, float hi) { return f2bf(lo) | (f2bf(hi) << 16); }
__device__ __forceinline__ float bf2f(unsigned b) { return __builtin_bit_cast(float, b << 16); }
__device__ __forceinline__ float bflo(unsigned w) { return __builtin_bit_cast(float, w << 16); }
__device__ __forceinline__ float bfhi(unsigned w) { return __builtin_bit_cast(float, w & 0xffff0000u); }
__device__ __forceinline__ unsigned f2h(float f) { const _Float16 h = (_Float16)f; return (unsigned)__builtin_bit_cast(unsigned short, h); }
__device__ __forceinline__ float h2f(unsigned h) { return (float)__builtin_bit_cast(_Float16, (unsigned short)h); }
__device__ __forceinline__ float sigmoidf_(float x) { return __builtin_amdgcn_rcpf(1.0f + __expf(-x)); }

#define XB_TMO      128
#define XB_XCNT(j)  (256  + 64 * (j))
#define XB_XSUB(j)  (1280 + 64 * (j))
#define XB_XGEN(j)  (2304 + 64 * (j))
#define XB_TOP      3328
#define XB_TOPGEN   3392
#define XCD_BAR_WORDS 3456
#define XB_SPIN_CAP (1u << 18)

__device__ __forceinline__ unsigned xb_ld(unsigned* p)              { return __hip_atomic_load(p, __ATOMIC_RELAXED, __HIP_MEMORY_SCOPE_AGENT); }
__device__ __forceinline__ unsigned xb_add(unsigned* p, unsigned v) { return __hip_atomic_fetch_add(p, v, __ATOMIC_RELAXED, __HIP_MEMORY_SCOPE_AGENT); }
__device__ __forceinline__ unsigned xb_xcc_id() { return (unsigned)__builtin_amdgcn_s_getreg((3 << 11) | 20) & 0xFu; }
#define XB_SPIN(cond, bar) do { unsigned _sp = 0; while (cond) { __builtin_amdgcn_s_sleep(1); \
    if ((++_sp & 255u) == 0u) { if (xb_ld(&(bar)[XB_TMO])) break; if (_sp > XB_SPIN_CAP) { atomicAdd(&(bar)[XB_TMO], 1u); break; } } } } while (0)

struct XcdBarrier {
    unsigned* bar; unsigned x;
    volatile LAS unsigned* st;
};
__device__ __forceinline__ XcdBarrier xcd_barrier_post(unsigned* bar, volatile LAS unsigned* st) {
    XcdBarrier b; b.bar = bar; b.x = xb_xcc_id(); b.st = st;
    if (threadIdx.x == 0) (void)xb_add(&bar[XB_XCNT(b.x)], 1u);
    return b;
}
__device__ __forceinline__ void xcd_barrier_complete(unsigned* bar, unsigned x, unsigned& nloc, unsigned& nx) {
    const unsigned G = gridDim.x * gridDim.y * gridDim.z;
    unsigned sum, cnt, mine, sp = 0u;
    for (;;) {
        sum = 0u; cnt = 0u; mine = 0u;
#pragma unroll
        for (unsigned j = 0; j < 16; ++j) { const unsigned c = xb_ld(&bar[XB_XCNT(j)]); sum += c; cnt += (c > 0u) ? 1u : 0u; mine = (j == x) ? c : mine; }
        if (sum == G) break;
        __builtin_amdgcn_s_sleep(1);
        if ((++sp & 255u) == 0u) { if (xb_ld(&bar[XB_TMO])) break; if (sp > XB_SPIN_CAP) { atomicAdd(&bar[XB_TMO], 1u); break; } }
    }
    nloc = mine > 0u ? mine : 1u; nx = cnt > 0u ? cnt : 1u;
}
__device__ __forceinline__ void xcd_barrier(const XcdBarrier& b) {
    asm volatile("s_waitcnt vmcnt(0)" ::: "memory");
    __syncthreads();
    if (threadIdx.x == 0) {
        unsigned* bar = b.bar;
        __builtin_amdgcn_s_waitcnt(0);
        unsigned nloc = b.st[0], nx = b.st[1];
        if (nloc == 0u) { xcd_barrier_complete(bar, b.x, nloc, nx); b.st[0] = nloc; b.st[1] = nx; }
        const unsigned old = xb_add(&bar[XB_XSUB(b.x)], 1u);
        const unsigned gen = old / nloc;
        if (old + 1u == (gen + 1u) * nloc) {
            __builtin_amdgcn_fence(__ATOMIC_RELEASE, "agent");
            asm volatile("s_waitcnt vmcnt(0)" ::: "memory");
            const unsigned og = xb_add(&bar[XB_TOP], 1u);
            const unsigned tg = og / nx;
            if (og + 1u == (tg + 1u) * nx) xb_add(&bar[XB_TOPGEN], 1u);
            else XB_SPIN(xb_ld(&bar[XB_TOPGEN]) == tg, bar);
            __builtin_amdgcn_fence(__ATOMIC_ACQUIRE, "agent");
            xb_add(&bar[XB_XGEN(b.x)], 1u);
            asm volatile("s_waitcnt vmcnt(0)" ::: "memory");
        } else {
            XB_SPIN(xb_ld(&bar[XB_XGEN(b.x)]) == gen, bar);
            __builtin_amdgcn_fence(__ATOMIC_ACQUIRE, "agent");
            asm volatile("s_waitcnt vmcnt(0)" ::: "memory");
        }
    }
    __syncthreads();
}

struct Frame {
    LAS unsigned char* lds;
    volatile LAS unsigned* MISC;
    gu32* ctl;
    int tid, lane, wave, G;
    const float* in[18];
    float* out;
    unsigned char* ws;
};
__device__ __forceinline__ float wave_sum(float v) {
#pragma unroll
    for (int o = 1; o < 64; o <<= 1) v += __shfl_xor(v, o);
    return v;
}

__device__ __forceinline__ void p0_transpose_item(const float* W, int N, bf16* WT, int ldk, int row_off, LAS float* scr, int item, int lane) {
    const int nblk = N / 32, kb = item / nblk, nb = item % nblk, k0 = 64 * kb, n0 = 32 * nb;
#pragma unroll 8
    for (int i = 0; i < 32; ++i) { const int kk = 2 * i + (lane >> 5); scr[kk * 33 + (lane & 31)] = W[(size_t)(k0 + kk) * N + n0 + (lane & 31)]; }
    LDS_WAIT(); asm volatile("" ::: "memory");
    const int c = lane & 7;
#pragma unroll
    for (int j = 0; j < 4; ++j) { const int n = (lane >> 3) + 8 * j; const LAS float* s = scr + (8 * c) * 33 + n;
        v4u o; o.x = pk2(s[0 * 33], s[1 * 33]); o.y = pk2(s[2 * 33], s[3 * 33]); o.z = pk2(s[4 * 33], s[5 * 33]); o.w = pk2(s[6 * 33], s[7 * 33]);
        *(GAS v4u*)(WT + (size_t)(row_off + n0 + n) * ldk + k0 + 8 * c) = o; }
    LDS_WAIT(); asm volatile("" ::: "memory");
}
__device__ __forceinline__ void p0_prologue(Frame& F) {
    const float* const (&in)[18] = F.in;
    unsigned char* ws = F.ws;
    const int gt = blockIdx.x * 512 + F.tid, GT = F.G * 512;
    { float* LB = (float*)(ws + WS_LB); const float* lg = in[9];
      for (int i = gt; i < 2 * HW; i += GT) { const float l0 = lg[i], l1 = lg[2 * HW + i]; LB[i] = 1.f / (1.f + expf(l1 - l0)); } }
    if (gt < 2 * NH) ((float*)(ws + WS_LAM))[gt] = -log1pf(expf(-in[11][gt]));
    { float* COS = (float*)(ws + WS_COS); float* SIN = (float*)(ws + WS_SIN);
      for (int i = gt; i < T * 64; i += GT) { const int t = i >> 6, j = i & 63, fi = j & 31; const int pos = (j < 32) ? (t >> 6) : (t & 63);
          const float inv = powf(10000.0f, -(float)fi / 32.0f); const float ang = (float)pos * inv; float s, c; sincosf(ang, &s, &c); COS[i] = c; SIN[i] = s; } }
    {
        LAS float* sv = (LAS float*)(F.lds);
        LAS float* red = (LAS float*)(F.lds + 49152);
        for (int i = F.tid; i < 3 * D; i += 512) { const int v = i / D, k = i % D; const float x = (v < 2) ? in[1][v * D + k] : in[3][k]; sv[i] = x / (1.0f + expf(-x)); }
        __syncthreads();
        float* MOD = (float*)(ws + WS_MOD);
        for (int item = blockIdx.x; item < NMOD / 96; item += F.G) {
            const int ks = F.tid / 24, cg = F.tid % 24;
            if (F.tid < 504) {
                f32x4 a0 = {0.f, 0.f, 0.f, 0.f}, a1 = a0, a2 = a0;
                const float* wp = in[4] + 96 * item + 4 * cg;
#pragma unroll 8
                for (int k = ks; k < D; k += 21) { const f32x4 w = *(const GAS f32x4*)(wp + (size_t)k * NMOD); a0 += w * sv[k]; a1 += w * sv[D + k]; a2 += w * sv[2 * D + k]; }
#pragma unroll
                for (int j = 0; j < 4; ++j) { red[(ks * 3 + 0) * 96 + 4 * cg + j] = a0[j]; red[(ks * 3 + 1) * 96 + 4 * cg + j] = a1[j]; red[(ks * 3 + 2) * 96 + 4 * cg + j] = a2[j]; }
            }
            __syncthreads();
            if (F.tid < 288) { const int v = F.tid / 96, n = F.tid % 96; float s = 0.f;
                for (int q = 0; q < 21; ++q) s += red[(q * 3 + v) * 96 + n];
                MOD[v * NMOD + 96 * item + n] = s + in[5][96 * item + n]; }
            __syncthreads();
        }
    }
    {
        LAS float* scr = (LAS float*)(F.lds + F.wave * 16384);
        const int gw = blockIdx.x * NWAVES + F.wave, NGW = F.G * NWAVES;
        constexpr int I_IN = (D / 64) * (NIN / 32);
        bf16* WIN = (bf16*)(ws + WS_WIN);
        for (int it = gw; it < I_IN; it += NGW) p0_transpose_item(in[8], NIN, WIN, D, 0, scr, it, F.lane);
    }
}
constexpr int CW_POOL = 2048;
__device__ __forceinline__ void deferred_pool(Frame& F) {
    constexpr int I_BR = (HW / 64) * (D / 32), I_O = (D / 64) * (D / 32), I_1 = (D / 64) * (DFF / 32), I_2 = (DFF / 64) * (D / 32);
    constexpr int NDEF = 2 * I_BR + I_O + I_1 + I_2, BATCH = 4;
    unsigned char* ws = F.ws;
    LAS float* scr = (LAS float*)(F.lds + F.wave * 16384);
    bf16* WBR = (bf16*)(ws + WS_WBR); bf16* WO = (bf16*)(ws + WS_WO); bf16* WF1 = (bf16*)(ws + WS_WF1); bf16* WF2 = (bf16*)(ws + WS_WF2);
    for (;;) {
        unsigned base = 0;
        if (F.lane == 0) base = __hip_atomic_fetch_add((unsigned*)(F.ctl + CW_POOL), (unsigned)BATCH, __ATOMIC_RELAXED, __HIP_MEMORY_SCOPE_AGENT);
        base = __builtin_amdgcn_readfirstlane(base);
        if (base >= (unsigned)NDEF) break;
        for (int q = 0; q < BATCH; ++q) {
            int r = (int)base + q; if (r >= NDEF) break;
            if (r < I_BR) { p0_transpose_item(F.in[12], D, WBR, HW, 0, scr, r, F.lane); continue; } r -= I_BR;
            if (r < I_BR) { p0_transpose_item(F.in[13], D, WBR, HW, D, scr, r, F.lane); continue; } r -= I_BR;
            if (r < I_O) { p0_transpose_item(F.in[14], D, WO, D, 0, scr, r, F.lane); continue; } r -= I_O;
            if (r < I_1) { p0_transpose_item(F.in[15], DFF, WF1, D, 0, scr, r, F.lane); continue; } r -= I_1;
            p0_transpose_item(F.in[16], D, WF2, DFF, 0, scr, r, F.lane);
        }
    }
}

__device__ __forceinline__ void rms_mod_row(int lane, const float* xrow, const float* g, const float* shift, const float* scale, bf16* orow) {
    const GAS f32x4* xr = (const GAS f32x4*)xrow + lane;
    f32x4 v[16]; float s = 0.f;
#pragma unroll
    for (int j = 0; j < 16; ++j) { v[j] = xr[64 * j]; s += (v[j].x * v[j].x + v[j].y * v[j].y) + (v[j].z * v[j].z + v[j].w * v[j].w); }
    const float rstd = 1.0f / sqrtf(wave_sum(s) * (1.0f / D) + EPS);
    const GAS f32x4* g4 = (const GAS f32x4*)g + lane; const GAS f32x4* sh4 = (const GAS f32x4*)shift + lane; const GAS f32x4* sc4 = (const GAS f32x4*)scale + lane;
    GAS v2u* o8 = (GAS v2u*)orow + lane;
#pragma unroll
    for (int j = 0; j < 16; ++j) { const f32x4 gg = g4[64 * j], sh = sh4[64 * j], sc = sc4[64 * j];
        const f32x4 o = v[j] * rstd * gg * (sc + 1.0f) + sh;
        v2u w; w.x = pk2(o.x, o.y); w.y = pk2(o.z, o.w); o8[64 * j] = w; }
}
__device__ __forceinline__ void rms_final_row(int lane, float* row, const float* g) {
    GAS f32x4* xr = (GAS f32x4*)row + lane;
    f32x4 v[16]; float s = 0.f;
#pragma unroll
    for (int j = 0; j < 16; ++j) { v[j] = xr[64 * j]; s += (v[j].x * v[j].x + v[j].y * v[j].y) + (v[j].z * v[j].z + v[j].w * v[j].w); }
    const float rstd = 1.0f / sqrtf(wave_sum(s) * (1.0f / D) + EPS);
    const GAS f32x4* g4 = (const GAS f32x4*)g + lane;
#pragma unroll
    for (int j = 0; j < 16; ++j) xr[64 * j] = v[j] * rstd * g4[64 * j];
}

template <int N> __device__ __forceinline__ float dpp_shr(float v) { return __builtin_bit_cast(float, __builtin_amdgcn_update_dpp(0, __builtin_bit_cast(int, v), 0x110 + N, 0xf, 0xf, false)); }
__device__ __forceinline__ float row_scan16(float v) { v += dpp_shr<1>(v); v += dpp_shr<2>(v); v += dpp_shr<4>(v); v += dpp_shr<8>(v); return v; }
template <int N> __device__ __forceinline__ float dpp_ror(float v) { return __builtin_bit_cast(float, __builtin_amdgcn_update_dpp(0, __builtin_bit_cast(int, v), 0x120 + N, 0xf, 0xf, false)); }
__device__ __forceinline__ float row_sum16(float v) { v += dpp_ror<8>(v); v += dpp_ror<4>(v); v += dpp_ror<2>(v); v += dpp_ror<1>(v); return v; }
struct EpiIn {
    static constexpr bool PERM = true;
    unsigned char* ws; const float* rlogit;
    template <int SEC>
    __device__ __forceinline__ void run(pg8::f32x4 (&acc)[2][2][4][2], const pg8::Unit& u, int ts, int wr, int wc, int fr, int fq) const {
        const bool isctx = u.pm >= 32;
        const int b = isctx ? (u.pm - 32) : (u.pm >> 4);
        const int tbase = isctx ? 0 : (u.pm & 15) * 256;
        const int Tlen = isctx ? CT : T;
        const int j0 = wc * 32 + 8 * fq;
        const float RS = 0.08838834764831845f;
        if constexpr (SEC == 1 || SEC == 2) {
            constexpr int d = SEC - 1;
            const int j0_ = j0, fr_ = fr;
#pragma unroll
            for (int ai = 0; ai < 2; ++ai) {
                const int chunk = isctx ? (2 * ai + wr) : ((u.pm & 15) * 4 + 2 * ai + wr);
#pragma unroll
                for (int bj = 0; bj < 2; ++bj) {
                    const int hd = 2 * ts + bj;
#pragma unroll
                    for (int n = 0; n < 2; ++n) {
                        int j0 = j0_, fr = fr_; asm volatile("" : "+v"(j0), "+v"(fr));
                        const f32x4 lbv = *(const GAS f32x4*)((const float*)(ws + WS_LB) + d * HW + hd * HD + j0 + 4 * n);
                        unsigned kpk[4][2], epk[4][2]; float kprev[4], eprev[4], total[4];
#pragma unroll
                        for (int e = 0; e < 4; ++e) {
                            float run = 0.f, kk[4], cx[4]; const float om = 1.0f - lbv[e];
#pragma unroll
                            for (int m = 0; m < 4; ++m) { const float z = acc[ai][bj][m][n][e]; const float ez = __builtin_amdgcn_exp2f(z * -1.44269504f), sg = __builtin_amdgcn_rcpf(1.0f + ez);
                                kk[m] = om * ez * sg;
                                const float lf = __builtin_amdgcn_logf(lbv[e] + om * sg);
                                const float p = row_scan16(lf); const float t = row_sum16(lf);
                                cx[m] = d ? (p + run - lf) : (p + run); run += t; }
                            total[e] = run;
#pragma unroll
                            for (int m = 0; m < 4; ++m) { const float c = d ? (run - cx[m]) : cx[m]; const float ke = kk[m] * __builtin_amdgcn_exp2f(-c), ee = __builtin_amdgcn_exp2f(c);
                                if (e & 1) { kpk[m][e >> 1] = pg8::cvt_pk_bf16(kprev[m], ke); epk[m][e >> 1] = pg8::cvt_pk_bf16(eprev[m], ee); } else { kprev[m] = ke; eprev[m] = ee; } }
                            __builtin_amdgcn_sched_barrier(0);
                        }
                        if (fr == 0) { const f32x4 et = {__builtin_amdgcn_exp2f(total[0]), __builtin_amdgcn_exp2f(total[1]), __builtin_amdgcn_exp2f(total[2]), __builtin_amdgcn_exp2f(total[3])};
                            float* elp = isctx ? (float*)(ws + WS_ELC) + ((size_t)((d * NB + b) * NH + hd) * (CT / 64) + chunk) * HD : (float*)(ws + WS_EL) + ((size_t)((d * NB + b) * NH + hd) * (T / 64) + chunk) * HD;
                            *(GAS f32x4*)(elp + j0 + 4 * n) = et; }
#pragma unroll
                        for (int m = 0; m < 4; ++m) {
                            const int t = tbase + ai * 128 + wr * 64 + m * 16 + fr;
                            const size_t hoff = ((size_t)(b * NH + hd) * Tlen + t) * HD + j0 + 4 * n;
                            bf16* dk = (bf16*)(ws + (isctx ? (WS_CX + (d == 0 ? 1 : 3) * 2 * MiB) : (d == 0 ? WS_KF : WS_KB))) + hoff;
                            v2u w2; w2.x = kpk[m][0]; w2.y = kpk[m][1];
                            *(GAS v2u*)dk = w2;
                            if (!isctx) { bf16* de = (bf16*)(ws + (d == 0 ? WS_LFF : WS_LFB)) + hoff;
                                v2u x2; x2.x = epk[m][0]; x2.y = epk[m][1];
                                *(GAS v2u*)de = x2; }
                        }
                        __builtin_amdgcn_sched_barrier(0);
                    }
                }
            }
            return;
        }
#pragma unroll
        for (int ai = 0; ai < 2; ++ai)
#pragma unroll
            for (int m = 0; m < 4; ++m) {
                const int tl = ai * 128 + wr * 64 + m * 16 + fr, t = tbase + tl;
                const int r = u.pm * 256 + tl;
#pragma unroll
                for (int bj = 0; bj < 2; ++bj) {
                    const pg8::f32x4 v0 = acc[ai][bj][m][0], v1 = acc[ai][bj][m][1];
                    float v[8] = {v0[0], v0[1], v0[2], v0[3], v1[0], v1[1], v1[2], v1[3]};
                    const int hd = 2 * ts + bj;
                    const size_t hoff = ((size_t)(b * NH + hd) * Tlen + t) * HD + j0;
                    if constexpr (SEC == 0 || SEC == 4) {
                        bf16* dst = (bf16*)(ws + (isctx ? (WS_CX + (SEC == 0 ? 0 : 6) * 2 * MiB) : (SEC == 0 ? WS_VH : WS_VR))) + hoff;
                        v4u w; w.x = pg8::cvt_pk_bf16(v[0], v[1]); w.y = pg8::cvt_pk_bf16(v[2], v[3]); w.z = pg8::cvt_pk_bf16(v[4], v[5]); w.w = pg8::cvt_pk_bf16(v[6], v[7]);
                        *(GAS v4u*)dst = w;
                    } else if constexpr (SEC == 3 || SEC == 7) {
                        if constexpr (SEC == 3) {
#pragma unroll
                            for (int e = 0; e < 8; ++e) v[e] *= RS;
                        }
                        if (!isctx) {
                            const f32x4 cs = *(const GAS f32x4*)((const float*)(ws + WS_COS) + t * 64 + (j0 >> 1));
                            const f32x4 sn = *(const GAS f32x4*)((const float*)(ws + WS_SIN) + t * 64 + (j0 >> 1));
#pragma unroll
                            for (int p = 0; p < 4; ++p) { const float a1 = v[2 * p], a2 = v[2 * p + 1]; v[2 * p] = a1 * cs[p] - a2 * sn[p]; v[2 * p + 1] = a1 * sn[p] + a2 * cs[p]; }
                        }
                        const float lamf = ((const float*)(ws + WS_LAM))[hd], lamb = ((const float*)(ws + WS_LAM))[NH + hd];
                        const int pos = m * 16 + fr;
                        const float cf = (float)(pos + 1) * lamf, cb = (float)(64 - pos) * lamb;
                        const float sf = __expf(SEC == 3 ? -cf : cf), sb = __expf(SEC == 3 ? -cb : cb);
                        bf16* dstf = (bf16*)(ws + (SEC == 3 ? (isctx ? (WS_CX + 5 * 2 * MiB) : WS_KR) : WS_QR)) + hoff;
                        bf16* dstb = (bf16*)(ws + (SEC == 3 ? (isctx ? (WS_CX + 2 * 2 * MiB) : WS_KRB) : WS_QRB)) + hoff;
                        v4u w; w.x = pg8::cvt_pk_bf16(v[0] * sf, v[1] * sf); w.y = pg8::cvt_pk_bf16(v[2] * sf, v[3] * sf); w.z = pg8::cvt_pk_bf16(v[4] * sf, v[5] * sf); w.w = pg8::cvt_pk_bf16(v[6] * sf, v[7] * sf);
                        *(GAS v4u*)dstf = w;
                        v4u x; x.x = pg8::cvt_pk_bf16(v[0] * sb, v[1] * sb); x.y = pg8::cvt_pk_bf16(v[2] * sb, v[3] * sb); x.z = pg8::cvt_pk_bf16(v[4] * sb, v[5] * sb); x.w = pg8::cvt_pk_bf16(v[6] * sb, v[7] * sb);
                        *(GAS v4u*)dstb = x;
                    } else if constexpr (SEC == 5) {
#pragma unroll
                        for (int e = 0; e < 8; ++e) v[e] = v[e] * sigmoidf_(v[e]) * RS;
                        bf16* dst = (bf16*)(ws + WS_QH) + hoff;
                        v4u w; w.x = pg8::cvt_pk_bf16(v[0], v[1]); w.y = pg8::cvt_pk_bf16(v[2], v[3]); w.z = pg8::cvt_pk_bf16(v[4], v[5]); w.w = pg8::cvt_pk_bf16(v[6], v[7]);
                        *(GAS v4u*)dst = w;
                    } else if constexpr (SEC == 6 || SEC == 8) {
#pragma unroll
                        for (int e = 0; e < 8; ++e) v[e] = v[e] * sigmoidf_(v[e]);
                        bf16* dst = (bf16*)(ws + (SEC == 6 ? WS_GH : WS_GR)) + (size_t)r * HW + hd * HD + j0;
                        v4u w; w.x = pg8::cvt_pk_bf16(v[0], v[1]); w.y = pg8::cvt_pk_bf16(v[2], v[3]); w.z = pg8::cvt_pk_bf16(v[4], v[5]); w.w = pg8::cvt_pk_bf16(v[6], v[7]);
                        *(GAS v4u*)dst = w;
                    } else {
#pragma unroll
                        for (int e = 0; e < 8; ++e) v[e] = sigmoidf_(v[e]);
                        bf16* dst = (bf16*)(ws + (SEC == 9 ? WS_SGH : WS_SGR)) + (size_t)r * D + ts * 256 + bj * 128 + j0;
                        v4u w; w.x = pg8::cvt_pk_bf16(v[0], v[1]); w.y = pg8::cvt_pk_bf16(v[2], v[3]); w.z = pg8::cvt_pk_bf16(v[4], v[5]); w.w = pg8::cvt_pk_bf16(v[6], v[7]);
                        *(GAS v4u*)dst = w;
                    }
                }
            }
    }
    __device__ __forceinline__ bool operator()(pg8::f32x4 (&acc)[2][2][4][2], const pg8::Unit& u, int wr, int wc, int fr, int fq) const {
        { const int ln = pg8::lane_now(); fr = ln & 15; fq = ln >> 4; }
        asm volatile("" : "+s"(wr), "+s"(wc));
        const int pn = u.pn;
        if (pn < 72) { const int sec = pn >> 3, ts = pn & 7;
            switch (sec) {
                case 0: run<0>(acc, u, ts, wr, wc, fr, fq); break;
                case 1: run<1>(acc, u, ts, wr, wc, fr, fq); break;
                case 2: run<2>(acc, u, ts, wr, wc, fr, fq); break;
                case 3: run<3>(acc, u, ts, wr, wc, fr, fq); break;
                case 4: run<4>(acc, u, ts, wr, wc, fr, fq); break;
                case 5: run<5>(acc, u, ts, wr, wc, fr, fq); break;
                case 6: run<6>(acc, u, ts, wr, wc, fr, fq); break;
                case 7: run<7>(acc, u, ts, wr, wc, fr, fq); break;
                default: run<8>(acc, u, ts, wr, wc, fr, fq); break;
            }
        } else if (pn < 88) run<9>(acc, u, pn - 72, wr, wc, fr, fq);
        else run<10>(acc, u, pn - 88, wr, wc, fr, fq);
        return true;
    }
};
struct InOrder {
    pg8::StaticOrder so;
    __device__ void init(int G, int c) { so.init(M, NIN, G, c); }
    __device__ bool next(int i, pg8::Unit& u) const {
        const long L = (long)i * so.G + so.c;
        if (L < so.nwg) return so.tile(L, u);
        const int j = (int)(L - so.nwg); if (j >= 2 * (NSTATE / 256)) return false;
        u.pm = 32 + (j & 1); u.pn = j >> 1; u.am = u.pm; u.bn = u.pn; u.kind = 0; return true;
    }
};
struct EpiMerge {
    static constexpr bool PERM = true;
    const bf16* SGH; const bf16* SGR; bf16* OUT;
    __device__ __forceinline__ bool operator()(pg8::f32x4 (&acc)[2][2][4][2], const pg8::Unit& u, int wr, int wc, int fr, int fq) const {
        { const int ln = pg8::lane_now(); fr = ln & 15; fq = ln >> 4; }
        const int row0 = u.pm * 256 + wr * 64 + fr, col0 = u.pn * 256 + wc * 32 + 8 * fq;
#pragma unroll
        for (int ai = 0; ai < 2; ++ai)
#pragma unroll
            for (int m = 0; m < 4; ++m) {
                const size_t ro = (size_t)(row0 + ai * 128 + m * 16) * D + col0;
#pragma unroll
                for (int bj = 0; bj < 2; ++bj) {
                    const v4u gr = *(const GAS v4u*)(SGR + ro + bj * 128);
                    float sr[8] = {bflo(gr.x), bfhi(gr.x), bflo(gr.y), bfhi(gr.y), bflo(gr.z), bfhi(gr.z), bflo(gr.w), bfhi(gr.w)};
#pragma unroll
                    for (int e = 0; e < 8; ++e) sr[e] = fmaxf(sr[e], 1e-30f);
                    if (u.kind == 0) {
                        const v4u gh = *(const GAS v4u*)(SGH + ro + bj * 128);
                        const float sh[8] = {bflo(gh.x), bfhi(gh.x), bflo(gh.y), bfhi(gh.y), bflo(gh.z), bfhi(gh.z), bflo(gh.w), bfhi(gh.w)};
#pragma unroll
                        for (int e = 0; e < 4; ++e) { acc[ai][bj][m][0][e] *= sh[e] / sr[e]; acc[ai][bj][m][1][e] *= sh[4 + e] / sr[4 + e]; }
                    } else {
                        const pg8::f32x4 v0 = acc[ai][bj][m][0], v1 = acc[ai][bj][m][1];
                        v4u w; w.x = pg8::cvt_pk_bf16(v0[0] * sr[0], v0[1] * sr[1]); w.y = pg8::cvt_pk_bf16(v0[2] * sr[2], v0[3] * sr[3]);
                        w.z = pg8::cvt_pk_bf16(v1[0] * sr[4], v1[1] * sr[5]); w.w = pg8::cvt_pk_bf16(v1[2] * sr[6], v1[3] * sr[7]);
                        *(GAS v4u*)(OUT + ro + bj * 128) = w;
                    }
                }
            }
        return u.kind != 0;
    }
};
struct MergeOrder {
    pg8::StaticOrder so;
    __device__ void init(int G, int c) { so.init(M, D, G, c); }
    __device__ bool next(int i, pg8::Unit& u) const {
        if (!so.next(i >> 1, u)) return false;
        u.kind = i & 1; u.am = u.pm + u.kind * (M / 256); u.bn = u.pn + u.kind * (D / 256); return true;
    }
};
struct EpiResGate {
    static constexpr bool PERM = false;
    const float* base; const float* gate  ; float* out;
    __device__ __forceinline__ bool operator()(pg8::f32x4 (&acc)[2][2][4][2], const pg8::Unit& u, int wr, int wc, int fr, int fq) const {
        { const int ln = pg8::lane_now(); fr = ln & 15; fq = ln >> 4; }
        const int row0 = u.pm * 256 + wr * 64 + fr, col0 = u.pn * 256 + wc * 32 + 4 * fq;
        const float* gp = gate + (size_t)(u.pm >> 4) * NMOD + col0;
        f32x4 gv[2][2];
#pragma unroll
        for (int bj = 0; bj < 2; ++bj)
#pragma unroll
            for (int n = 0; n < 2; ++n) gv[bj][n] = *(const GAS f32x4*)(gp + bj * 128 + n * 16);
#pragma unroll
        for (int ai = 0; ai < 2; ++ai)
#pragma unroll
            for (int m = 0; m < 4; ++m) { const size_t ro = (size_t)(row0 + ai * 128 + m * 16) * D + col0;
#pragma unroll
                for (int bj = 0; bj < 2; ++bj)
#pragma unroll
                    for (int n = 0; n < 2; ++n) { const f32x4 bs = *(const GAS f32x4*)(base + ro + bj * 128 + n * 16);
                        *(GAS f32x4*)(out + ro + bj * 128 + n * 16) = bs + gv[bj][n] * acc[ai][bj][m][n]; }
                asm volatile("" ::: "memory"); }
        return true;
    }
};
struct EpiRelu2 {
    static constexpr bool PERM = true;
    bf16* O;
    __device__ __forceinline__ bool operator()(pg8::f32x4 (&acc)[2][2][4][2], const pg8::Unit& u, int wr, int wc, int fr, int fq) const {
        { const int ln = pg8::lane_now(); fr = ln & 15; fq = ln >> 4; }
        const int row0 = u.pm * 256 + wr * 64 + fr, col0 = u.pn * 256 + wc * 32 + 8 * fq;
#pragma unroll
        for (int ai = 0; ai < 2; ++ai)
#pragma unroll
            for (int m = 0; m < 4; ++m) { bf16* rowp = O + (size_t)(row0 + ai * 128 + m * 16) * DFF + col0;
#pragma unroll
                for (int bj = 0; bj < 2; ++bj) { pg8::f32x4 v0 = acc[ai][bj][m][0], v1 = acc[ai][bj][m][1];
#pragma unroll
                    for (int e = 0; e < 4; ++e) { const float a = fmaxf(v0[e], 0.f), c = fmaxf(v1[e], 0.f); v0[e] = a * a; v1[e] = c * c; }
                    v4u w; w.x = pg8::cvt_pk_bf16(v0[0], v0[1]); w.y = pg8::cvt_pk_bf16(v0[2], v0[3]); w.z = pg8::cvt_pk_bf16(v1[0], v1[1]); w.w = pg8::cvt_pk_bf16(v1[2], v1[3]);
                    *(GAS v4u*)(rowp + bj * 128) = w; } }
        return true;
    }
};

constexpr int SC_QE = 0, SC_KE = 16384, SC_VV = 32768, SC_ST = 49152, SC_EL = 49152 + 2 * 17408, SC_END = SC_EL + 512;
static_assert(SC_END <= RING_BYTES, "scan LDS");
__device__ __forceinline__ unsigned off_b(unsigned row, unsigned ch) { return 256u * row + 16u * (ch ^ (((row & 3u) << 2) | ((row >> 2) & 3u))); }
__device__ __forceinline__ s16x4 tr_rd(LAS unsigned char* p) { return __builtin_amdgcn_ds_read_tr16_b64_v4i16((LAS s16x4*)p); }
__device__ __forceinline__ void scan_mfma(LAS unsigned char* L, LAS bf16* STc, LAS bf16* STn, LAS float* EL, bf16* Og, bool isc, int dir, size_t tok0_, int h, int vh, int w, int c16, int g, int qq, int pp, int tt, int vp, f32x4 (&accS)[4]) {
        if (!isc) {
            bf16x8 Qf[4];
#pragma unroll
            for (int ks = 0; ks < 4; ++ks) Qf[ks] = *(const LAS bf16x8*)(L + SC_QE + off_b(16 * tt + c16, 4 * ks + g));
            f32x4 sc[4];
#pragma unroll
            for (int a = 0; a < 4; ++a) { sc[a] = (f32x4){0.f, 0.f, 0.f, 0.f};
#pragma unroll
                for (int ks = 0; ks < 4; ++ks) { const bf16x8 Af = *(const LAS bf16x8*)(L + SC_KE + off_b(16 * a + c16, 4 * ks + g));
                    sc[a] = __builtin_amdgcn_mfma_f32_16x16x32_bf16(Af, Qf[ks], sc[a], 0, 0, 0); }
                const int tcol = 16 * tt + c16;
#pragma unroll
                for (int i = 0; i < 4; ++i) { const int sidx = 16 * a + 4 * g + i; const bool keep = dir ? (sidx >= tcol) : (sidx <= tcol); sc[a][i] = keep ? sc[a][i] : 0.f; }
            }
            bf16x8 Pf[2];
#pragma unroll
            for (int kp = 0; kp < 2; ++kp) { v4u p; p.x = pg8::cvt_pk_bf16(sc[2 * kp][0], sc[2 * kp][1]); p.y = pg8::cvt_pk_bf16(sc[2 * kp][2], sc[2 * kp][3]);
                p.z = pg8::cvt_pk_bf16(sc[2 * kp + 1][0], sc[2 * kp + 1][1]); p.w = pg8::cvt_pk_bf16(sc[2 * kp + 1][2], sc[2 * kp + 1][3]);
                Pf[kp] = __builtin_bit_cast(bf16x8, p); }
            const size_t tok0 = tok0_;
#pragma unroll
            for (int q2 = 0; q2 < 2; ++q2) { const int vt = 2 * vp + q2;
                f32x4 o = {0.f, 0.f, 0.f, 0.f};
#pragma unroll
                for (int ks = 0; ks < 4; ++ks) { const bf16x8 Af = *(const LAS bf16x8*)(STc + (16 * vt + c16) * 136 + 32 * ks + 8 * g);
                    o = __builtin_amdgcn_mfma_f32_16x16x32_bf16(Af, Qf[ks], o, 0, 0, 0); }
#pragma unroll
                for (int kp = 0; kp < 2; ++kp) {
                    const s16x4 lo = tr_rd(L + SC_VV + off_b(32 * kp + 4 * g + qq, 2 * (4 * vh + vt) + (pp >> 1)) + 8 * (pp & 1));
                    const s16x4 hi = tr_rd(L + SC_VV + off_b(32 * kp + 16 + 4 * g + qq, 2 * (4 * vh + vt) + (pp >> 1)) + 8 * (pp & 1));
                    const bf16x8 Af = __builtin_shufflevector(lo, hi, 0, 1, 2, 3, 4, 5, 6, 7);
                    o = __builtin_amdgcn_mfma_f32_16x16x32_bf16(Af, Pf[kp], o, 0, 0, 0); }
                v2u ow; ow.x = pg8::cvt_pk_bf16(o[0], o[1]); ow.y = pg8::cvt_pk_bf16(o[2], o[3]);
                *(GAS v2u*)(Og + (tok0 + 16 * tt + c16) * HW + h * HD + vh * 64 + 16 * vt + 4 * g) = ow;
            }
        }
        {
            bf16x8 Kf[2];
#pragma unroll
            for (int kp = 0; kp < 2; ++kp) {
                const s16x4 lo = tr_rd(L + SC_KE + off_b(32 * kp + 8 * g + qq, 2 * w + (pp >> 1)) + 8 * (pp & 1));
                const s16x4 hi = tr_rd(L + SC_KE + off_b(32 * kp + 8 * g + 4 + qq, 2 * w + (pp >> 1)) + 8 * (pp & 1));
                Kf[kp] = __builtin_shufflevector(lo, hi, 0, 1, 2, 3, 4, 5, 6, 7); }
            const f32x4 el = *(const LAS f32x4*)(EL + 16 * w + 4 * g);
#pragma unroll
            for (int vt = 0; vt < 4; ++vt) {
#pragma unroll
                for (int kp = 0; kp < 2; ++kp) {
                    const s16x4 lo = tr_rd(L + SC_VV + off_b(32 * kp + 8 * g + qq, 2 * (4 * vh + vt) + (pp >> 1)) + 8 * (pp & 1));
                    const s16x4 hi = tr_rd(L + SC_VV + off_b(32 * kp + 8 * g + 4 + qq, 2 * (4 * vh + vt) + (pp >> 1)) + 8 * (pp & 1));
                    const bf16x8 Bf = __builtin_shufflevector(lo, hi, 0, 1, 2, 3, 4, 5, 6, 7);
                    accS[vt] = __builtin_amdgcn_mfma_f32_16x16x32_bf16(Kf[kp], Bf, accS[vt], 0, 0, 0); }
                accS[vt] = accS[vt] * el;
                v2u sw; sw.x = pg8::cvt_pk_bf16(accS[vt][0], accS[vt][1]); sw.y = pg8::cvt_pk_bf16(accS[vt][2], accS[vt][3]);
                *(LAS v2u*)(STn + (16 * vt + c16) * 136 + 16 * w + 4 * g) = sw;
            }
        }
}
__device__ __forceinline__ void scan_unit(Frame& F, int unit) {
    const int tid = F.tid, lane = F.lane, w = F.wave;
    const int vh = (unit >> 3) & 1, dir = (unit >> 4) & 1, rest = (unit & 7) | ((unit >> 5) << 3);
    const int br = rest & 1, b = (rest >> 1) & 1, h = rest >> 2;
    unsigned char* ws = F.ws;
    const bf16* Qg = (const bf16*)(ws + (br ? (dir ? WS_QRB : WS_QR) : WS_QH));
    const bf16* Eg = (const bf16*)(ws + (dir ? WS_LFB : WS_LFF));
    const bf16* Kg = (const bf16*)(ws + (br ? (dir ? WS_KRB : WS_KR) : (dir ? WS_KB : WS_KF)));
    const bf16* Vg = (const bf16*)(ws + (br ? WS_VR : WS_VH));
    const bf16* Kc = (const bf16*)(ws + WS_CX + (size_t)(br ? (dir ? 2 : 5) : (dir ? 3 : 1)) * 2 * MiB);
    const bf16* Vc = (const bf16*)(ws + WS_CX + (size_t)(br ? 6 : 0) * 2 * MiB);
    const float* ELg = (const float*)(ws + WS_EL) + (size_t)((dir * NB + b) * NH + h) * (T / 64) * HD;
    const float* ELc = (const float*)(ws + WS_ELC) + (size_t)((dir * NB + b) * NH + h) * (CT / 64) * HD;
    bf16* Og = (bf16*)(ws + WS_O + (size_t)(br * 2 + dir) * 32 * MiB);
    float elr = 1.f;
    if (br) elr = __expf(64.0f * ((const float*)(ws + WS_LAM))[dir * NH + h]);
    LAS unsigned char* L = F.lds + RING_OFF;
    LAS bf16* ST = (LAS bf16*)(L + SC_ST); LAS float* EL = (LAS float*)(L + SC_EL);
    f32x4 accS[4];
#pragma unroll
    for (int i = 0; i < 4; ++i) accS[i] = (f32x4){0.f, 0.f, 0.f, 0.f};
    const int c16 = lane & 15, g = lane >> 4, qq = c16 >> 2, pp = c16 & 3;
    const int tt = w & 3, vp = w >> 2;
    const unsigned lo0 = off_b((unsigned)tid >> 4, (unsigned)tid & 15), lo1 = off_b(((unsigned)tid >> 4) + 32, (unsigned)tid & 15);
    const unsigned lov = off_b((unsigned)tid >> 3, (unsigned)(vh * 8 + (tid & 7)));
    v4u rq0A, rq1A, re0A, re1A, rk0A, rk1A, rvA, rq0B, rq1B, re0B, re1B, rk0B, rk1B, rvB; float relA = 1.f, relB = 1.f;
    rq0A = rq1A = re0A = re1A = rq0B = rq1B = re0B = re1B = (v4u){0u, 0u, 0u, 0u};
    constexpr int NSTEP = 4 + T / 64;
    static_assert(NSTEP % 2 == 0, "the step loop is unrolled by two");
#define SCAN_LOAD(step_, X) do { const int st_ = (step_); const bool isc_ = st_ < 4; const int ci_ = isc_ ? (dir ? 3 - st_ : st_) : (dir ? (T / 64 - 1) - (st_ - 4) : (st_ - 4)); \
        const size_t tb_ = isc_ ? ((size_t)(b * NH + h) * CT + 64 * ci_) * HD : ((size_t)(b * NH + h) * T + 64 * ci_) * HD; \
        const GAS v4u* kp_ = (const GAS v4u*)((isc_ ? Kc : Kg) + tb_) + tid; rk0##X = kp_[0]; rk1##X = kp_[512]; \
        rv##X = *(const GAS v4u*)((isc_ ? Vc : Vg) + tb_ + (size_t)(tid >> 3) * HD + vh * 64 + (tid & 7) * 8); \
        if (!isc_) { const GAS v4u* qp_ = (const GAS v4u*)(Qg + tb_) + tid; rq0##X = qp_[0]; rq1##X = qp_[512]; \
            if (!br) { const GAS v4u* ep_ = (const GAS v4u*)(Eg + tb_) + tid; re0##X = ep_[0]; re1##X = ep_[512]; } } \
        if (!br && tid < HD) rel##X = (isc_ ? ELc : ELg)[ci_ * HD + tid]; } while (0)
#define MULQE(q_, e_) pg8::cvt_pk_bf16(bflo(q_) * bflo(e_), bfhi(q_) * bfhi(e_))
#define SCAN_STEP(step_, X) do { const int step = (step_); \
        const bool isc = step < 4; \
        const int ci = isc ? (dir ? 3 - step : step) : (dir ? (T / 64 - 1) - (step - 4) : (step - 4)); \
          \
        __syncthreads();                                     \
        *(LAS v4u*)(L + SC_KE + lo0) = rk0##X; *(LAS v4u*)(L + SC_KE + lo1) = rk1##X; \
        *(LAS v4u*)(L + SC_VV + lov) = rv##X; \
        if (!isc) { \
            if (!br) { v4u a, c2; \
                a.x = MULQE(rq0##X.x, re0##X.x); a.y = MULQE(rq0##X.y, re0##X.y); a.z = MULQE(rq0##X.z, re0##X.z); a.w = MULQE(rq0##X.w, re0##X.w); \
                c2.x = MULQE(rq1##X.x, re1##X.x); c2.y = MULQE(rq1##X.y, re1##X.y); c2.z = MULQE(rq1##X.z, re1##X.z); c2.w = MULQE(rq1##X.w, re1##X.w); \
                *(LAS v4u*)(L + SC_QE + lo0) = a; *(LAS v4u*)(L + SC_QE + lo1) = c2; \
            } else { *(LAS v4u*)(L + SC_QE + lo0) = rq0##X; *(LAS v4u*)(L + SC_QE + lo1) = rq1##X; } \
        } \
        if (tid < HD) EL[tid] = br ? elr : rel##X; \
        __syncthreads(); \
        if (step + 2 < NSTEP) SCAN_LOAD(step + 2, X); \
        LAS bf16* STc = ST + (step & 1) * (64 * 136); LAS bf16* STn = ST + ((step + 1) & 1) * (64 * 136); \
        scan_mfma(L, STc, STn, EL, Og, isc, dir, (size_t)b * T + 64 * ci, h, vh, w, c16, g, qq, pp, tt, vp, accS); } while (0)
    SCAN_LOAD(0, A); SCAN_LOAD(1, B);
    for (int step2 = 0; step2 < NSTEP; step2 += 2) { SCAN_STEP(step2, A); SCAN_STEP(step2 + 1, B); }
#undef SCAN_STEP
#undef SCAN_LOAD
#undef MULQE
    __syncthreads();
}

__device__ __forceinline__ void p4_combine(Frame& F) {
    unsigned char* ws = F.ws;
    const int gw = blockIdx.x * NWAVES + F.wave, NGW = F.G * NWAVES;
    const int sub = F.lane >> 4, l16 = F.lane & 15;
    const float* gain = F.in[10];
    const f32x4 ga = *(const GAS f32x4*)(gain + 8 * l16), gb = *(const GAS f32x4*)(gain + 8 * l16 + 4);
    const float gn[8] = {ga[0], ga[1], ga[2], ga[3], gb[0], gb[1], gb[2], gb[3]};
    constexpr int NIT = 2 * M * NH / 4;
    for (int it = gw; it < NIT; it += NGW) {
        const int idx = it * 4 + sub;
        const int br = idx / (M * NH), th = idx % (M * NH);
        const size_t eo = (size_t)th * HD + 8 * l16;
        const v4u a = *(const GAS v4u*)((const bf16*)(ws + WS_O + (size_t)(br * 2 + 0) * 32 * MiB) + eo);
        const v4u c = *(const GAS v4u*)((const bf16*)(ws + WS_O + (size_t)(br * 2 + 1) * 32 * MiB) + eo);
        const v4u gg = *(const GAS v4u*)((const bf16*)(ws + (br ? WS_GR : WS_GH)) + eo);
        float o[8] = {bflo(a.x) + bflo(c.x), bfhi(a.x) + bfhi(c.x), bflo(a.y) + bflo(c.y), bfhi(a.y) + bfhi(c.y), bflo(a.z) + bflo(c.z), bfhi(a.z) + bfhi(c.z), bflo(a.w) + bflo(c.w), bfhi(a.w) + bfhi(c.w)};
        const float gt[8] = {bflo(gg.x), bfhi(gg.x), bflo(gg.y), bfhi(gg.y), bflo(gg.z), bfhi(gg.z), bflo(gg.w), bfhi(gg.w)};
        float s = 0.f;
#pragma unroll
        for (int e = 0; e < 8; ++e) s += o[e];
#pragma unroll
        for (int d = 1; d < 16; d <<= 1) s += __shfl_xor(s, d);
        const float mu = br ? s * (1.0f / HD) : 0.f;
        float q = 0.f;
#pragma unroll
        for (int e = 0; e < 8; ++e) { o[e] -= mu; q += o[e] * o[e]; }
#pragma unroll
        for (int d = 1; d < 16; d <<= 1) q += __shfl_xor(q, d);
        const float rstd = 1.0f / sqrtf(q * (1.0f / HD) + EPS);
        float y[8];
#pragma unroll
        for (int e = 0; e < 8; ++e) y[e] = o[e] * rstd * (br ? 1.0f : gn[e]) * gt[e];
        v4u wv; wv.x = pk2(y[0], y[1]); wv.y = pk2(y[2], y[3]); wv.z = pk2(y[4], y[5]); wv.w = pk2(y[6], y[7]);
        *(GAS v4u*)((bf16*)(ws + WS_Y + (size_t)br * 32 * MiB) + eo) = wv;
    }
}

struct Args { const float* in[18]; float* out; unsigned char* ws; int ph_lo, ph_hi; };
__global__ void __launch_bounds__(NWAVES * 64, 2) fwd_kernel(Args args) {
    extern __shared__ __attribute__((aligned(16))) unsigned char lds[];
    Frame F;
    F.lds = (LAS unsigned char*)lds;
    F.MISC = (volatile LAS unsigned*)(F.lds + MISC_OFF);
    F.tid = threadIdx.x; F.lane = F.tid & 63; F.wave = __builtin_amdgcn_readfirstlane(F.tid >> 6);
    F.G = gridDim.x;
#pragma unroll
    for (int i = 0; i < 18; ++i) F.in[i] = args.in[i];
    F.out = args.out; F.ws = args.ws;
    unsigned char* ws = args.ws;
    F.ctl = (gu32*)(ws + WS_CTL);
    for (int u = F.tid; u < (LDS_BYTES - LDSCTL_OFF) / 4; u += NWAVES * 64) ((LAS unsigned*)(F.lds + LDSCTL_OFF))[u] = 0u;
    __syncthreads();
    XcdBarrier bar; bar.bar = (unsigned*)(F.ctl + CW_BAR); bar.x = 0; bar.st = nullptr;
    if (!MK_SPLIT) bar = xcd_barrier_post((unsigned*)(F.ctl + CW_BAR), F.MISC + 8);
    const int lo = args.ph_lo, hi = args.ph_hi;
#define IN(k) (lo <= (k) && (k) < hi)
#define SEAM(k) do { if (IN(k) && IN((k) + 1)) xcd_barrier(bar); } while (0)
    const int gw = blockIdx.x * NWAVES + F.wave, NGW = F.G * NWAVES;
    float* MOD = (float*)(ws + WS_MOD);

    if (IN(0)) { _Pragma("unroll") DUP(0) { p0_prologue(F); __syncthreads(); } }
    SEAM(0);
    F.lane = pg8::lane_now(); F.tid = F.wave * 64 + F.lane;
    if (IN(1)) {
        bf16* ACT = (bf16*)(ws + WS_ACT);
        for (int r = gw; r < MA; r += NGW) {
            const bool isx = r < M; const int mv = isx ? (r / T) : 2;
            const float* xrow = isx ? args.in[0] + (size_t)r * D : args.in[2] + (size_t)(r - M) * D;
            rms_mod_row(F.lane, xrow, args.in[6], MOD + (size_t)mv * NMOD + 0 * D, MOD + (size_t)mv * NMOD + 1 * D, ACT + (size_t)r * D);
        }
    }
    SEAM(1);
    if (IN(2)) {
        pg8::Gemm g{(const bf16*)(ws + WS_ACT), (const bf16*)(ws + WS_WIN), D}; InOrder S; S.init(F.G, (int)blockIdx.x);
        EpiIn E{ws, args.in[11]};
        _Pragma("unroll") DUP(2) { pg8::gemm_phase<EpiIn, InOrder>(F.lds + RING_OFF, g, S, E, F.wave); }
        F.lane = pg8::lane_now(); F.tid = F.wave * 64 + F.lane;
        deferred_pool(F);
    }
    SEAM(2);
    F.lane = pg8::lane_now(); F.tid = F.wave * 64 + F.lane;
    if (IN(3)) { _Pragma("unroll") DUP(3) { for (int u = blockIdx.x; u < 256; u += F.G) scan_unit(F, u); } }
    SEAM(3);
    F.lane = pg8::lane_now(); F.tid = F.wave * 64 + F.lane;
    if (IN(4)) { p4_combine(F); }
    SEAM(4);
    if (IN(5)) {
        pg8::Gemm g{(const bf16*)(ws + WS_Y), (const bf16*)(ws + WS_WBR), HW}; MergeOrder S; S.init(F.G, (int)blockIdx.x);
        EpiMerge E{(const bf16*)(ws + WS_SGH), (const bf16*)(ws + WS_SGR), (bf16*)(ws + WS_ACT)};
        pg8::gemm_phase<EpiMerge, MergeOrder>(F.lds + RING_OFF, g, S, E, F.wave);
    }
    SEAM(5);
    if (IN(6)) {
        pg8::Gemm g{(const bf16*)(ws + WS_ACT), (const bf16*)(ws + WS_WO), D}; pg8::StaticOrder S; S.init(M, D, F.G, (int)blockIdx.x);
        EpiResGate E{args.in[0], MOD + 2 * D, (float*)(ws + WS_X1)};
        pg8::gemm_phase<EpiResGate, pg8::StaticOrder>(F.lds + RING_OFF, g, S, E, F.wave);
    }
    SEAM(6);
    F.lane = pg8::lane_now(); F.tid = F.wave * 64 + F.lane;
    if (IN(7)) {
        bf16* ACT = (bf16*)(ws + WS_ACT); const float* X1 = (const float*)(ws + WS_X1);
        for (int r = gw; r < M; r += NGW) { const int mv = r / T;
            rms_mod_row(F.lane, X1 + (size_t)r * D, args.in[7], MOD + (size_t)mv * NMOD + 3 * D, MOD + (size_t)mv * NMOD + 4 * D, ACT + (size_t)r * D); }
    }
    SEAM(7);
    if (IN(8)) {
        pg8::Gemm g{(const bf16*)(ws + WS_ACT), (const bf16*)(ws + WS_WF1), D}; pg8::StaticOrder S; S.init(M, DFF, F.G, (int)blockIdx.x);
        EpiRelu2 E{(bf16*)(ws + WS_FFA)};
        _Pragma("unroll") DUP(8) { pg8::gemm_phase<EpiRelu2, pg8::StaticOrder>(F.lds + RING_OFF, g, S, E, F.wave); }
    }
    SEAM(8);
    if (IN(9)) {
        pg8::Gemm g{(const bf16*)(ws + WS_FFA), (const bf16*)(ws + WS_WF2), DFF}; pg8::StaticOrder S; S.init(M, D, F.G, (int)blockIdx.x);
        EpiResGate E{(const float*)(ws + WS_X1), MOD + 5 * D, args.out};
        pg8::gemm_phase<EpiResGate, pg8::StaticOrder>(F.lds + RING_OFF, g, S, E, F.wave);
    }
    SEAM(9);
    F.lane = pg8::lane_now(); F.tid = F.wave * 64 + F.lane;
    if (IN(10)) {
        for (int r = gw; r < M; r += NGW) rms_final_row(F.lane, args.out + (size_t)r * D, args.in[17]);
    }
#undef IN
#undef SEAM
}

extern "C" void kernel_launch(void* const* d_in, const int* in_sizes, int n_in, void* d_out, int out_size, void* d_ws, size_t ws_size, hipStream_t stream) {
    static int grid = 0;
    if (grid == 0) {
        if (n_in != 18 || in_sizes[0] != M * D || out_size != M * D || ws_size < WS_END) { fprintf(stderr, "kernel_launch: unexpected shapes / workspace (%d inputs, in0 %d, out %d, ws %zu < %zu)\n", n_in, n_in > 0 ? in_sizes[0] : -1, out_size, ws_size, (size_t)WS_END); grid = -1; return; }
        int dev = 0, cus = 0, per_cu = 0;
        if (hipGetDevice(&dev) != hipSuccess || hipDeviceGetAttribute(&cus, hipDeviceAttributeMultiprocessorCount, dev) != hipSuccess) { grid = -1; return; }
        if (hipFuncSetAttribute((const void*)fwd_kernel, hipFuncAttributeMaxDynamicSharedMemorySize, LDS_BYTES) != hipSuccess) { fprintf(stderr, "kernel_launch: hipFuncSetAttribute failed\n"); grid = -1; return; }
        if (hipOccupancyMaxActiveBlocksPerMultiprocessor(&per_cu, (const void*)fwd_kernel, NWAVES * 64, LDS_BYTES) != hipSuccess || per_cu < 1)
            fprintf(stderr, "kernel_launch: note: occupancy query reports %d workgroups per CU\n", per_cu);
        (void)hipGetLastError();
        grid = cus;
    }
    if (grid < 0) return;
    if (hipMemsetAsync((char*)d_ws + WS_CTL, 0, CTL_ZERO_BYTES, stream) != hipSuccess) return;
    Args a{};
    for (int i = 0; i < 18; ++i) a.in[i] = (const float*)d_in[i];
    a.out = (float*)d_out; a.ws = (unsigned char*)d_ws;
#if MK_SPLIT
    for (int p = 0; p < N_PHASES; ++p) { a.ph_lo = p; a.ph_hi = p + 1; hipLaunchKernelGGL(fwd_kernel, dim3(grid), dim3(NWAVES * 64), LDS_BYTES, stream, a); }
#else
    a.ph_lo = 0; a.ph_hi = N_PHASES;
    hipLaunchKernelGGL(fwd_kernel, dim3(grid), dim3(NWAVES * 64), LDS_BYTES, stream, a);
#endif
    const hipError_t le = hipPeekAtLastError();
    if (le != hipSuccess) fprintf(stderr, "kernel_launch: launch failed: %s\n", hipGetErrorName(le));
}
```
